# Optimizing an MI355X kernel written in HIP

```python
import math
import jax, jax.numpy as jnp
from jax import lax
import numpy as np

D_MODEL = 1024
BATCH = 16
SEQ = 2048
DEPTH = 2

RWKV_HEADS = 8
RWKV_HEAD_DIM = 64
RWKV_WIDTH = RWKV_HEADS * RWKV_HEAD_DIM
RWKV_DECAY_RANK = 64
RWKV_ICLR_RANK = 64
RWKV_GATE_RANK = 128
RWKV_SHIFT_COLS = 3 * RWKV_WIDTH + RWKV_DECAY_RANK + RWKV_ICLR_RANK + RWKV_GATE_RANK
RWKV_LN_EPS = 64e-5
SSD_HEADS = 8
SSD_HEAD_DIM = 64
SSD_WIDTH = SSD_HEADS * SSD_HEAD_DIM
SSD_GROUPS = 2
SSD_STATE = 128
SSD_CONV = 4
SSD_CHUNK = 128
SSD_XBC = SSD_WIDTH + 2 * SSD_GROUPS * SSD_STATE
SSD_NORM_EPS = 1e-5
S5_GROUP = 16
S5_GROUPS = 32
S5_WIDTH = S5_GROUP * S5_GROUPS
S5_STATE = 64
N_BRANCHES = 3
FFN_HIDDEN = -(-8 * D_MODEL // (3 * 256)) * 256
NORM_EPS = 1e-6
IN_COLS = RWKV_SHIFT_COLS + SSD_WIDTH + SSD_XBC + SSD_HEADS + S5_WIDTH + N_BRANCHES * D_MODEL

kernel_name = "hybrid_rwkv7_ssd_s5_gated_trunk"


def _rms_norm(x, g, eps=NORM_EPS):
    xf = x.astype(jnp.float32)
    y = xf * lax.rsqrt(jnp.mean(xf * xf, axis=-1, keepdims=True) + eps)
    return (y * g.astype(jnp.float32)).astype(x.dtype)


def _token_shift(p):
    return jnp.pad(p, ((0, 0), (1, 0), (0, 0)))[:, :-1]


def _rwkv7_mixer(p, mu, w0, w_up, a0, a_up, g_up, k_k, k_a, r_k, ln_g, ln_b):
    f32 = jnp.float32
    bsz, T, _ = p.shape
    H, N, W = RWKV_HEADS, RWKV_HEAD_DIM, RWKV_WIDTH
    p = p + (_token_shift(p) - p) * mu
    r, k, v, wd, ad, gd = jnp.split(
        p, [W, 2 * W, 3 * W, 3 * W + RWKV_DECAY_RANK, 3 * W + RWKV_DECAY_RANK + RWKV_ICLR_RANK], axis=-1)
    w_log = -jax.nn.softplus(-(w0 + jnp.tanh(wd) @ w_up).astype(f32)) - 0.5
    decay = jnp.exp(-jnp.exp(w_log))
    a = jax.nn.sigmoid((a0 + ad @ a_up).astype(f32))
    g = jax.nn.sigmoid(gd) @ g_up
    heads = lambda t: t.reshape(bsz, T, H, N)
    kk = heads(k * k_k).astype(f32)
    kk = kk / jnp.maximum(jnp.linalg.norm(kk, axis=-1, keepdims=True), 1e-12)
    k = k.astype(f32) * (1.0 + (a - 1.0) * k_a)
    rh, kh, vh, wh, ah = heads(r.astype(f32)), heads(k), heads(v.astype(f32)), heads(decay), heads(a)

    def step(S, inp):
        r_t, w_t, k_t, v_t, kk_t, a_t = inp
        sa = jnp.einsum('bhvk,bhk->bhv', S, -kk_t)
        S = (S * w_t[:, :, None, :] + sa[..., None] * (kk_t * a_t)[:, :, None, :]
             + v_t[..., None] * k_t[:, :, None, :])
        return S, jnp.einsum('bhvk,bhk->bhv', S, r_t)

    tm = lambda t: jnp.moveaxis(t, 1, 0)
    S0 = jnp.zeros((bsz, H, N, N), f32)
    _, o = lax.scan(step, S0, (tm(rh), tm(wh), tm(kh), tm(vh), tm(kk), tm(ah)))
    o = jnp.moveaxis(o, 0, 1)
    mean = jnp.mean(o, axis=-1, keepdims=True)
    var = jnp.var(o, axis=-1, keepdims=True)
    o = ((o - mean) * lax.rsqrt(var + RWKV_LN_EPS)).reshape(bsz, T, W) * ln_g + ln_b
    bonus = jnp.sum(rh * kh * r_k, axis=-1, keepdims=True) * vh
    o = o + bonus.reshape(bsz, T, W)
    return (o * g).astype(p.dtype)


def _segsum(x):
    L = x.shape[-1]
    cs = jnp.cumsum(x, axis=-1)
    diff = cs[..., :, None] - cs[..., None, :]
    mask = jnp.tril(jnp.ones((L, L), dtype=bool))
    return jnp.where(mask, diff, -jnp.inf)


def _ssd_chunked(x, dA, Bm, Cm):
    b, T, H, P = x.shape
    G, N = Bm.shape[2], Bm.shape[3]
    J, L = H // G, SSD_CHUNK
    nc = T // L
    xc = x.reshape(b, nc, L, G, J, P)
    Bc = Bm.reshape(b, nc, L, G, N)
    Cc = Cm.reshape(b, nc, L, G, N)
    A = dA.reshape(b, nc, L, G, J).transpose(0, 3, 4, 1, 2)
    A_cs = jnp.cumsum(A, axis=-1)
    Lmat = jnp.exp(_segsum(A))
    scores = jnp.einsum('bclgn,bcsgn->bgcls', Cc, Bc)
    y_diag = jnp.einsum('bgjcls,bcsgjp->bclgjp', scores[:, :, None] * Lmat, xc)
    decay_states = jnp.exp(A_cs[..., -1:] - A_cs)
    states = jnp.einsum('bclgn,bgjcl,bclgjp->bcgjpn', Bc, decay_states, xc)
    states = jnp.concatenate([jnp.zeros_like(states[:, :1]), states], axis=1)
    chunk_decay = jnp.exp(_segsum(jnp.pad(A_cs[..., -1], ((0, 0), (0, 0), (0, 0), (1, 0)))))
    states = jnp.einsum('bgjzc,bcgjpn->bzgjpn', chunk_decay, states)[:, :-1]
    y_off = jnp.einsum('bclgn,bcgjpn,bgjcl->bclgjp', Cc, states, jnp.exp(A_cs))
    return (y_diag + y_off).reshape(b, T, H, P)


def _mamba2_mixer(z, xbc, dt_raw, conv_w, conv_b, dt_bias, a_log, d_skip, norm_g):
    f32 = jnp.float32
    bsz, T, _ = z.shape
    xbc = lax.conv_general_dilated(
        xbc, conv_w[:, None, :], window_strides=(1,), padding=[(SSD_CONV - 1, 0)],
        dimension_numbers=('NWC', 'WIO', 'NWC'), feature_group_count=SSD_XBC) + conv_b
    xbc = jax.nn.silu(xbc)
    xs, Bm, Cm = jnp.split(xbc, [SSD_WIDTH, SSD_WIDTH + SSD_GROUPS * SSD_STATE], axis=-1)
    xs = xs.astype(f32).reshape(bsz, T, SSD_HEADS, SSD_HEAD_DIM)
    Bm = Bm.astype(f32).reshape(bsz, T, SSD_GROUPS, SSD_STATE)
    Cm = Cm.astype(f32).reshape(bsz, T, SSD_GROUPS, SSD_STATE)
    dt = jax.nn.softplus((dt_raw + dt_bias).astype(f32))
    A = -jnp.exp(a_log.astype(f32))
    y = _ssd_chunked(xs * dt[..., None], dt * A, Bm, Cm) + xs * d_skip.astype(f32)[:, None]
    y = y.reshape(bsz, T, SSD_WIDTH) * jax.nn.silu(z.astype(f32))
    yg = y.reshape(bsz, T, SSD_GROUPS, SSD_WIDTH // SSD_GROUPS)
    yg = yg * lax.rsqrt(jnp.mean(yg * yg, axis=-1, keepdims=True) + SSD_NORM_EPS)
    return (yg.reshape(bsz, T, SSD_WIDTH) * norm_g).astype(z.dtype)


def _complex_affine_combine(e1, e2):
    a1r, a1i, b1r, b1i = e1
    a2r, a2i, b2r, b2i = e2
    return (a2r * a1r - a2i * a1i, a2r * a1i + a2i * a1r,
            a2r * b1r - a2i * b1i + b2r, a2r * b1i + a2i * b1r + b2i)


def _s5_mixer(u, lam_re, lam_im, log_step, b_re, b_im, c_re, c_im, d_skip, glu_w, glu_b):
    f32 = jnp.float32
    bsz, T, _ = u.shape
    G, N = S5_GROUPS, S5_STATE
    uf = u.astype(f32)
    lr, li = lam_re.astype(f32), lam_im.astype(f32)
    step = jnp.exp(log_step.astype(f32))[:, None]
    mag = jnp.exp(lr * step)
    ab_re, ab_im = mag * jnp.cos(li * step), mag * jnp.sin(li * step)
    den = lr * lr + li * li
    coef_re = ((ab_re - 1.0) * lr + ab_im * li) / den
    coef_im = (ab_im * lr - (ab_re - 1.0) * li) / den
    br, bi = b_re.astype(f32), b_im.astype(f32)
    bb_re = coef_re[..., None] * br - coef_im[..., None] * bi
    bb_im = coef_re[..., None] * bi + coef_im[..., None] * br
    ug = uf.reshape(bsz, T, G, S5_GROUP)
    bu_re = jnp.einsum('btgi,gni->btgn', ug, bb_re)
    bu_im = jnp.einsum('btgi,gni->btgn', ug, bb_im)
    a_re = jnp.broadcast_to(ab_re, (1, T, G, N))
    a_im = jnp.broadcast_to(ab_im, (1, T, G, N))
    _, _, s_re, s_im = lax.associative_scan(_complex_affine_combine, (a_re, a_im, bu_re, bu_im), axis=1)
    y = (jnp.einsum('btgn,gon->btgo', s_re, c_re.astype(f32))
         - jnp.einsum('btgn,gon->btgo', s_im, c_im.astype(f32)))
    y = y.reshape(bsz, T, S5_WIDTH) + d_skip.astype(f32) * uf
    zg = jax.nn.gelu(y)
    out = zg * jax.nn.sigmoid(zg @ glu_w.astype(f32) + glu_b.astype(f32))
    return out.astype(u.dtype)


def setup_inputs(seed: int = 0) -> dict:
    key = jax.random.key(seed)
    f32 = jnp.float32
    L = DEPTH

    def nrm(i, shape, scale=1.0):
        return jax.random.normal(jax.random.fold_in(key, i), shape, f32) * scale

    def unif(i, shape, lo, hi):
        return jax.random.uniform(jax.random.fold_in(key, i), shape, f32, lo, hi)

    ssd_dt = jnp.exp(unif(17, (L, SSD_HEADS), math.log(1e-3), math.log(1e-1)))
    return {
        "x": nrm(0, (BATCH, SEQ, D_MODEL)),
        "norm_mix": 1.0 + nrm(1, (L, D_MODEL), 0.02),
        "w_in": nrm(2, (L, D_MODEL, IN_COLS), D_MODEL ** -0.5),
        "rwkv_mu": unif(3, (L, RWKV_SHIFT_COLS), 0.0, 1.0),
        "rwkv_w0": jnp.linspace(-6.0, -1.0, RWKV_WIDTH, dtype=f32) + nrm(4, (L, RWKV_WIDTH), 0.1),
        "rwkv_w_up": nrm(5, (L, RWKV_DECAY_RANK, RWKV_WIDTH), 0.1 * RWKV_DECAY_RANK ** -0.5),
        "rwkv_a0": nrm(6, (L, RWKV_WIDTH), 0.1),
        "rwkv_a_up": nrm(7, (L, RWKV_ICLR_RANK, RWKV_WIDTH), 0.1 * RWKV_ICLR_RANK ** -0.5),
        "rwkv_g_up": nrm(8, (L, RWKV_GATE_RANK, RWKV_WIDTH), RWKV_GATE_RANK ** -0.5),
        "rwkv_k_k": 0.85 + nrm(9, (L, RWKV_WIDTH), 0.05),
        "rwkv_k_a": 1.0 + nrm(10, (L, RWKV_WIDTH), 0.05),
        "rwkv_r_k": nrm(11, (L, RWKV_HEADS, RWKV_HEAD_DIM), 0.1),
        "rwkv_ln_g": 1.0 + nrm(12, (L, RWKV_WIDTH), 0.02),
        "rwkv_ln_b": nrm(13, (L, RWKV_WIDTH), 0.02),
        "proj_a": nrm(14, (L, RWKV_WIDTH, D_MODEL), RWKV_WIDTH ** -0.5),
        "ssd_conv_w": nrm(15, (L, SSD_CONV, SSD_XBC), SSD_CONV ** -0.5),
        "ssd_conv_b": nrm(16, (L, SSD_XBC), 0.02),
        "ssd_dt_bias": ssd_dt + jnp.log(-jnp.expm1(-ssd_dt)),
        "ssd_a_log": jnp.log(unif(18, (L, SSD_HEADS), 1.0, 16.0)),
        "ssd_d": 1.0 + nrm(19, (L, SSD_HEADS), 0.02),
        "ssd_norm_g": 1.0 + nrm(20, (L, SSD_WIDTH), 0.02),
        "proj_b": nrm(21, (L, SSD_WIDTH, D_MODEL), SSD_WIDTH ** -0.5),
        "s5_lam_re": -0.5 + nrm(22, (L, S5_GROUPS, S5_STATE), 0.01),
        "s5_lam_im": math.pi * jnp.arange(S5_STATE, dtype=f32) + nrm(23, (L, S5_GROUPS, S5_STATE), 0.01),
        "s5_log_step": unif(24, (L, S5_GROUPS), math.log(1e-3), math.log(1e-1)),
        "s5_b_re": nrm(25, (L, S5_GROUPS, S5_STATE, S5_GROUP), (2.0 * S5_GROUP) ** -0.5),
        "s5_b_im": nrm(26, (L, S5_GROUPS, S5_STATE, S5_GROUP), (2.0 * S5_GROUP) ** -0.5),
        "s5_c_re": nrm(27, (L, S5_GROUPS, S5_GROUP, S5_STATE), S5_STATE ** -0.5),
        "s5_c_im": nrm(28, (L, S5_GROUPS, S5_GROUP, S5_STATE), S5_STATE ** -0.5),
        "s5_d": nrm(29, (L, S5_WIDTH)),
        "s5_glu_w": nrm(30, (L, S5_WIDTH, S5_WIDTH), S5_WIDTH ** -0.5),
        "s5_glu_b": nrm(31, (L, S5_WIDTH), 0.02),
        "proj_c": nrm(32, (L, S5_WIDTH, D_MODEL), S5_WIDTH ** -0.5),
        "w_out": nrm(33, (L, D_MODEL, D_MODEL), D_MODEL ** -0.5),
        "norm_ffn": 1.0 + nrm(34, (L, D_MODEL), 0.02),
        "ffn_w_in": nrm(35, (L, D_MODEL, 2 * FFN_HIDDEN), D_MODEL ** -0.5),
        "ffn_w_out": nrm(36, (L, FFN_HIDDEN, D_MODEL), FFN_HIDDEN ** -0.5),
        "final_norm": 1.0 + nrm(37, (D_MODEL,), 0.02),
    }


def reference(x, norm_mix, w_in, rwkv_mu, rwkv_w0, rwkv_w_up, rwkv_a0, rwkv_a_up, rwkv_g_up,
              rwkv_k_k, rwkv_k_a, rwkv_r_k, rwkv_ln_g, rwkv_ln_b, proj_a,
              ssd_conv_w, ssd_conv_b, ssd_dt_bias, ssd_a_log, ssd_d, ssd_norm_g, proj_b,
              s5_lam_re, s5_lam_im, s5_log_step, s5_b_re, s5_b_im, s5_c_re, s5_c_im, s5_d,
              s5_glu_w, s5_glu_b, proj_c, w_out, norm_ffn, ffn_w_in, ffn_w_out, final_norm):
    bsz, T, _ = x.shape
    o1 = RWKV_SHIFT_COLS
    o2 = o1 + SSD_WIDTH
    o3 = o2 + SSD_XBC
    o4 = o3 + SSD_HEADS
    o5 = o4 + S5_WIDTH
    for l in range(DEPTH):
        h = _rms_norm(x, norm_mix[l])
        proj = h @ w_in[l]
        p_rwkv, z, xbc, dt_raw, u, gate_logits = jnp.split(proj, [o1, o2, o3, o4, o5], axis=-1)
        y_a = _rwkv7_mixer(p_rwkv, rwkv_mu[l], rwkv_w0[l], rwkv_w_up[l], rwkv_a0[l], rwkv_a_up[l],
                           rwkv_g_up[l], rwkv_k_k[l], rwkv_k_a[l], rwkv_r_k[l],
                           rwkv_ln_g[l], rwkv_ln_b[l]) @ proj_a[l]
        y_b = _mamba2_mixer(z, xbc, dt_raw, ssd_conv_w[l], ssd_conv_b[l], ssd_dt_bias[l],
                            ssd_a_log[l], ssd_d[l], ssd_norm_g[l]) @ proj_b[l]
        y_c = _s5_mixer(u, s5_lam_re[l], s5_lam_im[l], s5_log_step[l], s5_b_re[l], s5_b_im[l],
                        s5_c_re[l], s5_c_im[l], s5_d[l], s5_glu_w[l], s5_glu_b[l]) @ proj_c[l]
        gates = jax.nn.sigmoid(gate_logits.astype(jnp.float32)).reshape(bsz, T, N_BRANCHES, D_MODEL)
        gates = gates.astype(x.dtype)
        merged = gates[:, :, 0] * y_a + gates[:, :, 1] * y_b + gates[:, :, 2] * y_c
        x = x + merged @ w_out[l]
        hf = _rms_norm(x, norm_ffn[l])
        gate, up = jnp.split(hf @ ffn_w_in[l], 2, axis=-1)
        x = x + (jax.nn.silu(gate) * up) @ ffn_w_out[l]
    return _rms_norm(x, final_norm)
```

```cpp
#include <hip/hip_runtime.h>
#include <hip/hip_cooperative_groups.h>
#include <cstdio>
#include <cstdint>
namespace cg = cooperative_groups;

namespace pg8 {
#define PG8_LAS __attribute__((address_space(3)))
typedef unsigned short bf16_t;
typedef short bf16x8 __attribute__((ext_vector_type(8)));
typedef float f32x4 __attribute__((ext_vector_type(4)));
typedef unsigned u32x4 __attribute__((ext_vector_type(4)));
constexpr int BM = 256, BK = 64, HALF = 128, HTB = HALF * BK * 2  , STAGE_BYTES = 8 * HTB, NXCD = 8, WGM = 8;

__host__ __device__ __forceinline__ int lds_byte(int r, int c) { const int st = (r >> 4) * 2 + (c >> 5), rr = r & 15, cc = c & 31, ob = rr * 64 + cc * 2; return st * 1024 + (ob ^ (((ob >> 9) & 1) << 5)); }
__host__ __device__ __forceinline__ void stage_rc(int b, int& R, int& C) { const int st = b / 1024, sb = b % 1024, swz = sb ^ (((sb >> 9) & 1) << 5); R = (st >> 1) * 16 + swz / 64; C = (st & 1) * 32 + (swz % 64) / 2; }
__host__ __device__ __forceinline__ int perm32(int rho) { const int n = rho >> 4, i = rho & 15; return 8 * (i >> 2) + 4 * n + (i & 3); }

struct Unit { int pm, pn; };
struct Gemm { const bf16_t* A; const bf16_t* Bt; int M, N, K; };

struct StaticOrder {
    int nM, nN, nwg, G, c;
    __host__ __device__ void init(int M, int N, int G_, int c_) { nM = M / BM; nN = N / BM; nwg = nM * nN; G = G_; c = c_; }
    __host__ __device__ bool next(int i, Unit& u) const {
        const long L = (long)i * G + c; if (L >= nwg) return false;
        int wgid = (int)L; { const int q = nwg / NXCD, r = nwg % NXCD, xcd = wgid % NXCD, off = wgid / NXCD; wgid = (xcd < r ? xcd * (q + 1) : r * (q + 1) + (xcd - r) * q) + off; }
        const int nig = WGM * nN, gid = wgid / nig, fm = gid * WGM, gsz = (nM - fm) < WGM ? (nM - fm) : WGM;
        u.pm = fm + ((wgid % nig) % gsz); u.pn = (wgid % nig) / gsz; return true;
    }
    __device__ __forceinline__ void a_ready(const Unit&) const {}
    __device__ __forceinline__ void done(const Unit&) const {}
};

template <class Epi, class Sched, bool ALIGN_EPI = false, bool SP2 = false>
__device__ __forceinline__ void gemm_phase(PG8_LAS unsigned char* lds, const Gemm g, const Sched& S, const Epi& E) {
    int tid_ = threadIdx.x; asm volatile("" : "+v"(tid_));
    const int tid = tid_, wid = __builtin_amdgcn_readfirstlane(tid >> 6), lane = tid & 63, wr = wid >> 2, wc = wid & 3, fr = lane & 15, fq = lane >> 4;
    const int K = g.K, nt = K / BK;
    unsigned voffA[2], voffB[2];
#pragma unroll
    for (int i = 0; i < 2; ++i) { int R, C; stage_rc(tid * 16 + i * 8192, R, C); const int Rb = Epi::PERM ? ((R & ~31) + perm32(R & 31)) : R;
        voffA[i] = (unsigned)(R * K + C) * 2u; voffB[i] = (unsigned)(Rb * K + C) * 2u; }
    const size_t kstep = (size_t)(BK * 2);
    const size_t hstep = (size_t)HALF * K * 2;
    const size_t tstep = 2 * hstep;
    const unsigned ldsw = (unsigned)wid * 1024u;
    const int aoff = lds_byte(wr * 64 + fr, fq * 8), boff = lds_byte(wc * 32 + fr, fq * 8);
#define PG8_SA(b, h) (((b) * 2 + (h)) * HTB)
#define PG8_SB(b, h) ((4 + (b) * 2 + (h)) * HTB)
#define PG8_STAGE(bufoff, gbase, voff) do { _Pragma("unroll") for (int _i = 0; _i < 2; ++_i) \
        __builtin_amdgcn_global_load_lds((const unsigned*)((const char*)(gbase) + (voff)[_i]), (PG8_LAS unsigned*)(lds + (bufoff) + ldsw + _i * 8192), 16, 0, 0); } while (0)
#define PG8_LDA(dst, b, h) do { _Pragma("unroll") for (int m = 0; m < 4; ++m) _Pragma("unroll") for (int k = 0; k < 2; ++k) dst[m][k] = *(const PG8_LAS bf16x8*)(lds + PG8_SA(b, h) + aoff + m * 2048 + k * 1024); } while (0)
#define PG8_LDB(dst, b, h) do { _Pragma("unroll") for (int n = 0; n < 2; ++n) _Pragma("unroll") for (int k = 0; k < 2; ++k) dst[n][k] = *(const PG8_LAS bf16x8*)(lds + PG8_SB(b, h) + boff + n * 2048 + k * 1024); } while (0)
#define PG8_MMA(ai, bj, At, Bt) do { __builtin_amdgcn_s_setprio(1); _Pragma("unroll") for (int m = 0; m < 4; ++m) _Pragma("unroll") for (int n = 0; n < 2; ++n) _Pragma("unroll") for (int k = 0; k < 2; ++k) \
        acc[ai][bj][m][n] = __builtin_amdgcn_mfma_f32_16x16x32_bf16(Bt[n][k], At[m][k], acc[ai][bj][m][n], 0, 0, 0); __builtin_amdgcn_s_setprio(0); } while (0)
#define PG8_WAIT_V(n) asm volatile("s_waitcnt vmcnt(" #n ")" ::: "memory")
#define PG8_WAIT_L(n) asm volatile("s_waitcnt lgkmcnt(" #n ")" ::: "memory")
#define PG8_BAR __builtin_amdgcn_s_barrier()
#define PG8_SCHED __builtin_amdgcn_sched_barrier(0)
    Unit cur, nxt; int ui = 0;
    if (!S.next(0, cur)) return;
    f32x4 acc[2][2][4][2];
#pragma unroll
    for (int a = 0; a < 2; ++a)
#pragma unroll
        for (int b = 0; b < 2; ++b)
#pragma unroll
            for (int m = 0; m < 4; ++m)
#pragma unroll
                for (int n = 0; n < 2; ++n) acc[a][b][m][n] = (f32x4){0.f, 0.f, 0.f, 0.f};
    bf16x8 At[4][2], B0[2][2], B1[2][2];
    const char* cA = (const char*)g.A + (size_t)cur.pm * tstep; const char* cB = (const char*)g.Bt + (size_t)cur.pn * tstep;
    S.a_ready(cur);
    if constexpr (SP2) {
        PG8_STAGE(PG8_SB(0, 0), cB, voffB); PG8_STAGE(PG8_SB(0, 1), cB + hstep, voffB); PG8_STAGE(PG8_SA(0, 0), cA, voffA); PG8_STAGE(PG8_SA(0, 1), cA + hstep, voffA);
        if (wr == 1) PG8_BAR;
        PG8_WAIT_V(2); PG8_BAR;
        PG8_STAGE(PG8_SB(1, 0), cB + kstep, voffB); PG8_STAGE(PG8_SA(1, 0), cA + kstep, voffA); PG8_STAGE(PG8_SB(1, 1), cB + hstep + kstep, voffB);
        PG8_WAIT_V(6); PG8_BAR;
    } else {
        PG8_STAGE(PG8_SB(0, 0), cB, voffB); PG8_STAGE(PG8_SA(0, 0), cA, voffA); PG8_STAGE(PG8_SB(0, 1), cB + hstep, voffB); PG8_STAGE(PG8_SA(0, 1), cA + hstep, voffA);
        if (wr == 1) PG8_BAR;
        PG8_WAIT_V(4); PG8_BAR;
        PG8_STAGE(PG8_SB(1, 0), cB + kstep, voffB); PG8_STAGE(PG8_SA(1, 0), cA + kstep, voffA); PG8_STAGE(PG8_SB(1, 1), cB + hstep + kstep, voffB);
        PG8_WAIT_V(6); PG8_BAR;
    }
    for (;;) {
        const bool has_next = S.next(ui + 1, nxt);
        const char* nA = has_next ? (const char*)g.A + (size_t)nxt.pm * tstep : cA; const char* nB = has_next ? (const char*)g.Bt + (size_t)nxt.pn * tstep : cB;
        for (int t = 0; t < nt; t += 2) {
            const bool last = (t == nt - 2);
            const char* a1 = cA + (size_t)(t + 1) * kstep;
            const char* a2 = last ? nA : cA + (size_t)(t + 2) * kstep; const char* b2 = last ? nB : cB + (size_t)(t + 2) * kstep;
            const char* a3 = a2 + kstep; const char* b3 = b2 + kstep;
            if (last && has_next) S.a_ready(nxt);
            if constexpr (SP2) {
            PG8_LDB(B0, 0, 0); PG8_LDB(B1, 0, 1); PG8_SCHED; PG8_LDA(At, 0, 0); PG8_STAGE(PG8_SA(1, 1), a1 + hstep, voffA);
            PG8_WAIT_V(8); PG8_WAIT_L(0); PG8_BAR; PG8_MMA(0, 0, At, B0); PG8_MMA(0, 1, At, B1); PG8_BAR; PG8_SCHED;
            PG8_LDA(At, 0, 1); PG8_STAGE(PG8_SB(0, 0), b2, voffB); PG8_STAGE(PG8_SB(0, 1), b2 + hstep, voffB); PG8_STAGE(PG8_SA(0, 0), a2, voffA);
            PG8_WAIT_V(8); PG8_WAIT_L(0); PG8_BAR; PG8_MMA(1, 0, At, B0); PG8_MMA(1, 1, At, B1); PG8_BAR; PG8_SCHED;
            PG8_LDB(B0, 1, 0); PG8_LDB(B1, 1, 1); PG8_SCHED; PG8_LDA(At, 1, 0); PG8_STAGE(PG8_SA(0, 1), a2 + hstep, voffA);
            PG8_WAIT_V(8); PG8_WAIT_L(0); PG8_BAR; PG8_MMA(0, 0, At, B0); PG8_MMA(0, 1, At, B1); PG8_BAR; PG8_SCHED;
            PG8_LDA(At, 1, 1); PG8_STAGE(PG8_SB(1, 0), b3, voffB); PG8_STAGE(PG8_SB(1, 1), b3 + hstep, voffB); PG8_STAGE(PG8_SA(1, 0), a3, voffA);
            PG8_WAIT_V(8); PG8_WAIT_L(0); PG8_BAR; PG8_MMA(1, 0, At, B0); PG8_MMA(1, 1, At, B1); PG8_BAR; PG8_SCHED;
            } else {
            PG8_LDB(B0, 0, 0); PG8_SCHED; PG8_LDA(At, 0, 0); PG8_STAGE(PG8_SA(1, 1), a1 + hstep, voffA);
            PG8_WAIT_L(8); PG8_BAR; PG8_WAIT_L(0); PG8_MMA(0, 0, At, B0); PG8_BAR; PG8_SCHED;
            PG8_LDB(B1, 0, 1); PG8_STAGE(PG8_SB(0, 0), b2, voffB);
            PG8_BAR; PG8_WAIT_L(0); PG8_MMA(0, 1, At, B1); PG8_BAR;
            PG8_LDA(At, 0, 1); PG8_STAGE(PG8_SA(0, 0), a2, voffA);
            PG8_BAR; PG8_WAIT_L(0); PG8_MMA(1, 0, At, B0); PG8_BAR; PG8_SCHED;
            PG8_STAGE(PG8_SB(0, 1), b2 + hstep, voffB);
            PG8_WAIT_V(6); PG8_BAR; PG8_MMA(1, 1, At, B1); PG8_BAR;
            PG8_LDB(B0, 1, 0); PG8_SCHED; PG8_LDA(At, 1, 0); PG8_STAGE(PG8_SA(0, 1), a2 + hstep, voffA);
            PG8_WAIT_L(8); PG8_BAR; PG8_WAIT_L(0); PG8_MMA(0, 0, At, B0); PG8_BAR; PG8_SCHED;
            PG8_LDB(B1, 1, 1); PG8_STAGE(PG8_SB(1, 0), b3, voffB);
            PG8_BAR; PG8_WAIT_L(0); PG8_MMA(0, 1, At, B1); PG8_BAR;
            PG8_LDA(At, 1, 1); PG8_STAGE(PG8_SA(1, 0), a3, voffA);
            PG8_BAR; PG8_WAIT_L(0); PG8_MMA(1, 0, At, B0); PG8_BAR; PG8_SCHED;
            PG8_STAGE(PG8_SB(1, 1), b3 + hstep, voffB);
            PG8_WAIT_V(6); PG8_BAR; PG8_MMA(1, 1, At, B1); PG8_BAR;
            }
        }
        if constexpr (ALIGN_EPI) { if (wr == 0) PG8_BAR; }
        if constexpr (!Epi::AFTER_DRAIN) { E(acc, cur, wr, wc, fr, fq); S.done(cur); }
        if (!has_next) break;
#pragma unroll
        for (int a = 0; a < 2; ++a)
#pragma unroll
            for (int b = 0; b < 2; ++b)
#pragma unroll
                for (int m = 0; m < 4; ++m)
#pragma unroll
                    for (int n = 0; n < 2; ++n) acc[a][b][m][n] = (f32x4){0.f, 0.f, 0.f, 0.f};
        cur = nxt; cA = nA; cB = nB; ++ui;
        if constexpr (ALIGN_EPI) { if (wr == 1) PG8_BAR; }
    }
    PG8_WAIT_V(0);
    if constexpr (!ALIGN_EPI) { if (wr == 0) PG8_BAR; }
    PG8_BAR;
    if constexpr (Epi::AFTER_DRAIN) { E.fused(acc, cur, wr, wc, fr, fq, lds, wid, lane); S.done(cur); }
#undef PG8_SA
#undef PG8_SB
#undef PG8_STAGE
#undef PG8_LDA
#undef PG8_LDB
#undef PG8_MMA
#undef PG8_WAIT_V
#undef PG8_WAIT_L
#undef PG8_BAR
#undef PG8_SCHED
}
}

#ifndef PG8_SP2
#define PG8_SP2 true
#endif
#ifndef PG8_ALIGN
#define PG8_ALIGN true
#endif

#define LAS __attribute__((address_space(3)))
typedef unsigned short bf16_t;
typedef short bf16x8 __attribute__((ext_vector_type(8)));
typedef float f32x4 __attribute__((ext_vector_type(4)));
typedef float f32x2 __attribute__((ext_vector_type(2)));
typedef unsigned u32x4 __attribute__((ext_vector_type(4)));
typedef unsigned u32x2 __attribute__((ext_vector_type(2)));

__device__ __forceinline__ unsigned f2bf(float f) { unsigned u = __builtin_bit_cast(unsigned, f); return (u + 0x7fffu + ((u >> 16) & 1u)) >> 16; }
__device__ __forceinline__ unsigned pk2(float lo, float hi) { unsigned r; asm volatile("v_cvt_pk_bf16_f32 %0, %1, %2" : "=v"(r) : "v"(lo), "v"(hi)); return r; }
__device__ __forceinline__ float bf_lo(unsigned w) { return __builtin_bit_cast(float, w << 16); }
__device__ __forceinline__ float bf_hi(unsigned w) { return __builtin_bit_cast(float, w & 0xffff0000u); }
__device__ __forceinline__ float bf2f(bf16_t b) { return __builtin_bit_cast(float, (unsigned)b << 16); }
__device__ __forceinline__ void unpack8(u32x4 v, float* o) { o[0] = bf_lo(v.x); o[1] = bf_hi(v.x); o[2] = bf_lo(v.y); o[3] = bf_hi(v.y); o[4] = bf_lo(v.z); o[5] = bf_hi(v.z); o[6] = bf_lo(v.w); o[7] = bf_hi(v.w); }
__device__ __forceinline__ u32x4 pack8(const float* o) { u32x4 v; v.x = pk2(o[0], o[1]); v.y = pk2(o[2], o[3]); v.z = pk2(o[4], o[5]); v.w = pk2(o[6], o[7]); return v; }
__device__ __forceinline__ float sigm(float x) { return __builtin_amdgcn_rcpf(1.f + __expf(-x)); }
__device__ __forceinline__ float ftanh(float x) { return 1.f - 2.f * __builtin_amdgcn_rcpf(1.f + __expf(2.f * x)); }
__device__ __forceinline__ float softplusf(float z) { return z > 20.f ? z : log1pf(expf(z)); }
template <int CTRL> __device__ __forceinline__ float dppf(float x) { return __builtin_bit_cast(float, __builtin_amdgcn_update_dpp(0, __builtin_bit_cast(int, x), CTRL, 0xf, 0xf, true)); }
__device__ __forceinline__ float red8(float x) { x += dppf<0xB1>(x); x += dppf<0x4E>(x); x += dppf<0x141>(x); return x; }
__device__ __forceinline__ float red16(float x) { x = red8(x); x += dppf<0x140>(x); return x; }
__device__ __forceinline__ float red32(float x) { x = red16(x); x += __shfl_xor(x, 16); return x; }
__device__ __forceinline__ float wave_sum(float x) { x = red32(x); x += __shfl_xor(x, 32); return x; }
__device__ __forceinline__ bf16x8 ldsfrag(const LAS bf16_t* base, int row, int stride, int k) { return *(const LAS bf16x8*)(base + row * stride + k); }
#define MFMA16(a, b, c) __builtin_amdgcn_mfma_f32_16x16x32_bf16((a), (b), (c), 0, 0, 0)

namespace pg8 {
struct EpiStore {
    static constexpr bool PERM = true, AFTER_DRAIN = false;
    bf16_t* O; int ldc;
    __device__ __forceinline__ void operator()(const f32x4 (&acc)[2][2][4][2], const Unit& u, int wr, int wc, int fr, int fq) const {
        const int row0 = u.pm * BM + wr * 64 + fr, col0 = u.pn * BM + wc * 32 + 8 * fq;
#pragma unroll
        for (int ai = 0; ai < 2; ++ai)
#pragma unroll
            for (int m = 0; m < 4; ++m) { bf16_t* rowp = O + (size_t)(row0 + ai * HALF + m * 16) * ldc + col0;
#pragma unroll
                for (int bj = 0; bj < 2; ++bj) { const f32x4 v0 = acc[ai][bj][m][0], v1 = acc[ai][bj][m][1];
                    u32x4 w; w.x = pk2(v0[0], v0[1]); w.y = pk2(v0[2], v0[3]); w.z = pk2(v1[0], v1[1]); w.w = pk2(v1[2], v1[3]);
                    *(u32x4*)(rowp + bj * HALF) = w; } }
    }
};
template <bool FIRST> struct EpiGate {
    static constexpr bool PERM = true, AFTER_DRAIN = false;
    const bf16_t* T; bf16_t* Mg;
    __device__ __forceinline__ void operator()(const f32x4 (&acc)[2][2][4][2], const Unit& u, int wr, int wc, int fr, int fq) const {
        const int row0 = u.pm * BM + wr * 64 + fr, col0 = u.pn * BM + wc * 32 + 8 * fq;
#pragma unroll
        for (int ai = 0; ai < 2; ++ai) {
            u32x4 tb[4][2], pb[4][2];
#pragma unroll
            for (int m = 0; m < 4; ++m)
#pragma unroll
                for (int bj = 0; bj < 2; ++bj) { const size_t ro = (size_t)(row0 + ai * HALF + m * 16) * 1024 + col0 + bj * HALF;
                    tb[m][bj] = *(const u32x4*)(T + ro); if (!FIRST) pb[m][bj] = *(const u32x4*)(Mg + ro); }
            asm volatile("" ::: "memory");
#pragma unroll
            for (int m = 0; m < 4; ++m)
#pragma unroll
                for (int bj = 0; bj < 2; ++bj) { const size_t ro = (size_t)(row0 + ai * HALF + m * 16) * 1024 + col0 + bj * HALF;
                    const f32x4 v0 = acc[ai][bj][m][0], v1 = acc[ai][bj][m][1];
                    float t[8], r[8]; unpack8(tb[m][bj], t);
                    r[0] = sigm(v0[0]) * t[0]; r[1] = sigm(v0[1]) * t[1]; r[2] = sigm(v0[2]) * t[2]; r[3] = sigm(v0[3]) * t[3];
                    r[4] = sigm(v1[0]) * t[4]; r[5] = sigm(v1[1]) * t[5]; r[6] = sigm(v1[2]) * t[6]; r[7] = sigm(v1[3]) * t[7];
                    if (!FIRST) { float p[8]; unpack8(pb[m][bj], p);
#pragma unroll
                        for (int e = 0; e < 8; ++e) r[e] += p[e]; }
                    *(u32x4*)(Mg + ro) = pack8(r); }
        }
    }
};
template <bool BASE_BF> struct EpiResid {
    static constexpr bool PERM = true, AFTER_DRAIN = false;
    const void* base; bf16_t* out;
    __device__ __forceinline__ void operator()(const f32x4 (&acc)[2][2][4][2], const Unit& u, int wr, int wc, int fr, int fq) const {
        const int row0 = u.pm * BM + wr * 64 + fr, col0 = u.pn * BM + wc * 32 + 8 * fq;
#pragma unroll
        for (int ai = 0; ai < 2; ++ai) {
            f32x4 bb[4][2][2]; u32x4 bh[4][2];
#pragma unroll
            for (int m = 0; m < 4; ++m)
#pragma unroll
                for (int bj = 0; bj < 2; ++bj) { const size_t ro = (size_t)(row0 + ai * HALF + m * 16) * 1024 + col0 + bj * HALF;
                    if (BASE_BF) bh[m][bj] = *(const u32x4*)((const bf16_t*)base + ro);
                    else { bb[m][bj][0] = *(const f32x4*)((const float*)base + ro); bb[m][bj][1] = *(const f32x4*)((const float*)base + ro + 4); } }
            asm volatile("" ::: "memory");
#pragma unroll
            for (int m = 0; m < 4; ++m)
#pragma unroll
                for (int bj = 0; bj < 2; ++bj) { const size_t ro = (size_t)(row0 + ai * HALF + m * 16) * 1024 + col0 + bj * HALF;
                    float b[8];
                    if (BASE_BF) unpack8(bh[m][bj], b);
                    else { b[0] = bb[m][bj][0].x; b[1] = bb[m][bj][0].y; b[2] = bb[m][bj][0].z; b[3] = bb[m][bj][0].w; b[4] = bb[m][bj][1].x; b[5] = bb[m][bj][1].y; b[6] = bb[m][bj][1].z; b[7] = bb[m][bj][1].w; }
                    const f32x4 v0 = acc[ai][bj][m][0], v1 = acc[ai][bj][m][1];
                    b[0] += v0[0]; b[1] += v0[1]; b[2] += v0[2]; b[3] += v0[3]; b[4] += v1[0]; b[5] += v1[1]; b[6] += v1[2]; b[7] += v1[3];
                    *(u32x4*)(out + ro) = pack8(b); }
        }
    }
};
struct EpiSwiglu {
    static constexpr bool PERM = true, AFTER_DRAIN = false;
    bf16_t* O;
    __device__ __forceinline__ void operator()(const f32x4 (&acc)[2][2][4][2], const Unit& u, int wr, int wc, int fr, int fq) const {
        const int row0 = u.pm * BM + wr * 64 + fr, col0 = u.pn * HALF + wc * 32 + 8 * fq;
#pragma unroll
        for (int ai = 0; ai < 2; ++ai)
#pragma unroll
            for (int m = 0; m < 4; ++m) { bf16_t* p = O + (size_t)(row0 + ai * HALF + m * 16) * 2816 + col0;
                float r[8];
#pragma unroll
                for (int n = 0; n < 2; ++n)
#pragma unroll
                    for (int e = 0; e < 4; ++e) { const float g = acc[ai][0][m][n][e], up = acc[ai][1][m][n][e]; r[4 * n + e] = g * sigm(g) * up; }
                *(u32x4*)p = pack8(r); }
    }
};
struct EpiSigU8 {
    static constexpr bool PERM = true, AFTER_DRAIN = false;
    unsigned char* O;
    __device__ __forceinline__ void operator()(const f32x4 (&acc)[2][2][4][2], const Unit& u, int wr, int wc, int fr, int fq) const {
        const int row0 = u.pm * BM + wr * 64 + fr, col0 = u.pn * BM + wc * 32 + 8 * fq;
#pragma unroll
        for (int ai = 0; ai < 2; ++ai)
#pragma unroll
            for (int m = 0; m < 4; ++m)
#pragma unroll
                for (int bj = 0; bj < 2; ++bj) { const f32x4 v0 = acc[ai][bj][m][0], v1 = acc[ai][bj][m][1];
                    unsigned q[8];
#pragma unroll
                    for (int e = 0; e < 4; ++e) { q[e] = (unsigned)(sigm(v0[e]) * 255.f + 0.5f); q[4 + e] = (unsigned)(sigm(v1[e]) * 255.f + 0.5f); }
                    u32x2 w; w.x = q[0] | (q[1] << 8) | (q[2] << 16) | (q[3] << 24); w.y = q[4] | (q[5] << 8) | (q[6] << 16) | (q[7] << 24);
                    *(u32x2*)(O + (size_t)(row0 + ai * HALF + m * 16) * 1024 + col0 + bj * HALF) = w; }
    }
};
struct EpiMulAccU8 {
    static constexpr bool PERM = true, AFTER_DRAIN = false;
    const unsigned char* G; bf16_t* Mg;
    __device__ __forceinline__ void operator()(const f32x4 (&acc)[2][2][4][2], const Unit& u, int wr, int wc, int fr, int fq) const {
        const int row0 = u.pm * BM + wr * 64 + fr, col0 = u.pn * BM + wc * 32 + 8 * fq;
#pragma unroll
        for (int ai = 0; ai < 2; ++ai) {
            u32x2 gb[4][2]; u32x4 pb[4][2];
#pragma unroll
            for (int m = 0; m < 4; ++m)
#pragma unroll
                for (int bj = 0; bj < 2; ++bj) { const size_t ro = (size_t)(row0 + ai * HALF + m * 16) * 1024 + col0 + bj * HALF;
                    gb[m][bj] = *(const u32x2*)(G + ro); pb[m][bj] = *(const u32x4*)(Mg + ro); }
            asm volatile("" ::: "memory");
#pragma unroll
            for (int m = 0; m < 4; ++m)
#pragma unroll
                for (int bj = 0; bj < 2; ++bj) { const size_t ro = (size_t)(row0 + ai * HALF + m * 16) * 1024 + col0 + bj * HALF;
                    const f32x4 v0 = acc[ai][bj][m][0], v1 = acc[ai][bj][m][1];
                    float p[8], r[8]; unpack8(pb[m][bj], p);
                    const unsigned ga = gb[m][bj].x, gc = gb[m][bj].y; const float k = 1.f / 255.f;
                    r[0] = p[0] + (float)(ga & 255u) * k * v0[0]; r[1] = p[1] + (float)((ga >> 8) & 255u) * k * v0[1]; r[2] = p[2] + (float)((ga >> 16) & 255u) * k * v0[2]; r[3] = p[3] + (float)(ga >> 24) * k * v0[3];
                    r[4] = p[4] + (float)(gc & 255u) * k * v1[0]; r[5] = p[5] + (float)((gc >> 8) & 255u) * k * v1[1]; r[6] = p[6] + (float)((gc >> 16) & 255u) * k * v1[2]; r[7] = p[7] + (float)(gc >> 24) * k * v1[3];
                    *(u32x4*)(Mg + ro) = pack8(r); }
        }
    }
};
struct EpiGlu {
    static constexpr bool PERM = true, AFTER_DRAIN = false;
    const bf16_t* Z; bf16_t* O; const float* bias;
    __device__ __forceinline__ void operator()(const f32x4 (&acc)[2][2][4][2], const Unit& u, int wr, int wc, int fr, int fq) const {
        const int row0 = u.pm * BM + wr * 64 + fr, col0 = u.pn * BM + wc * 32 + 8 * fq;
        f32x4 bv[2][2];
#pragma unroll
        for (int bj = 0; bj < 2; ++bj) { bv[bj][0] = *(const f32x4*)(bias + col0 + bj * HALF); bv[bj][1] = *(const f32x4*)(bias + col0 + bj * HALF + 4); }
#pragma unroll
        for (int ai = 0; ai < 2; ++ai) {
            u32x4 zb[4][2];
#pragma unroll
            for (int m = 0; m < 4; ++m)
#pragma unroll
                for (int bj = 0; bj < 2; ++bj) zb[m][bj] = *(const u32x4*)(Z + (size_t)(row0 + ai * HALF + m * 16) * 512 + col0 + bj * HALF);
            asm volatile("" ::: "memory");
#pragma unroll
            for (int m = 0; m < 4; ++m)
#pragma unroll
                for (int bj = 0; bj < 2; ++bj) { const f32x4 v0 = acc[ai][bj][m][0], v1 = acc[ai][bj][m][1];
                    float z[8], r[8]; unpack8(zb[m][bj], z);
#pragma unroll
                    for (int e = 0; e < 4; ++e) { r[e] = z[e] * sigm(v0[e] + bv[bj][0][e]); r[4 + e] = z[4 + e] * sigm(v1[e] + bv[bj][1][e]); }
                    *(u32x4*)(O + (size_t)(row0 + ai * HALF + m * 16) * 512 + col0 + bj * HALF) = pack8(r); }
        }
    }
};
}

constexpr int DM = 1024, BATCH = 16, SEQ = 2048, MTOK = BATCH * SEQ, DEPTH = 2;
constexpr int IN_COLS = 6920, NPROJ = 3840, FFH = 2816;
constexpr int P_R = 0, P_K = 512, P_V = 1024, P_WD = 1536, P_AD = 1600, P_GD = 1664, P_Z = 1792, P_XS = 2304, P_B = 2816, P_C = 3072, P_U = 3328;
constexpr int NWAVES = 8, NTHR = 512;
constexpr size_t MiB = 1u << 20, KiB = 1u << 10;
constexpr size_t WS_WIN = 1 * MiB, WS_WG = 9 * MiB, WS_PA = 15 * MiB, WS_PB = 16 * MiB, WS_PC = 17 * MiB, WS_GLU = 18 * MiB, WS_WOUT = 19 * MiB,
                 WS_FIN = 21 * MiB, WS_FOUT = 32 * MiB, WS_WUP = 38 * MiB, WS_AUP = 38 * MiB + 64 * KiB, WS_GUP = 38 * MiB + 128 * KiB, WS_A16 = 38 * MiB + 256 * KiB,
                 WS_TM = 39 * MiB, WS_M3 = 45 * MiB, WS_DT = 47 * MiB, WS_H = 48 * MiB, WS_YA = 112 * MiB, WS_YB = 144 * MiB, WS_YC = 176 * MiB, WS_ZG = 208 * MiB,
                 WS_PROJ = 240 * MiB, WS_GC8 = 480 * MiB  , WS_END = 512 * MiB;
constexpr size_t WS_XF = 416 * MiB;
constexpr size_t WS_MERGED = WS_PROJ, WS_TT = WS_PROJ + 64 * MiB, WS_ACT = WS_PROJ;
constexpr int LDS_BYTES = 151552;

struct Args { const float* in[38]; float* out; unsigned char* ws; };
typedef const __attribute__((address_space(4))) Args* KArgs;
typedef const __attribute__((address_space(4))) Args& KArgsRef;
__device__ __forceinline__ KArgs kargs() { KArgs p = (KArgs)__builtin_amdgcn_kernarg_segment_ptr(); asm volatile("" : "+s"(p)); return p; }
__device__ __forceinline__ int opq(int x) { asm volatile("" : "+v"(x)); return x; }

__device__ __forceinline__ void tr_item(const float* __restrict__ W, int ldw, int k0, int c0, bf16_t* __restrict__ WT, int K, int n0, LAS float* scr, int lane) {
    float wv_[32];
#pragma unroll
    for (int i = 0; i < 32; ++i) { const int kk = 2 * i + (lane >> 5); wv_[i] = W[(size_t)(k0 + kk) * ldw + c0 + (lane & 31)]; }
#pragma unroll
    for (int i = 0; i < 32; ++i) { const int kk = 2 * i + (lane >> 5); scr[kk * 33 + (lane & 31)] = wv_[i]; }
    asm volatile("s_waitcnt lgkmcnt(0)" ::: "memory");
    const int c = lane & 7;
#pragma unroll
    for (int j = 0; j < 4; ++j) { const int n = (lane >> 3) + 8 * j; const LAS float* s = scr + (8 * c) * 33 + n;
        u32x4 o; o.x = pk2(s[0 * 33], s[1 * 33]); o.y = pk2(s[2 * 33], s[3 * 33]); o.z = pk2(s[4 * 33], s[5 * 33]); o.w = pk2(s[6 * 33], s[7 * 33]);
        *(u32x4*)(WT + (size_t)(n0 + n) * K + k0 + 8 * c) = o; }
    asm volatile("s_waitcnt lgkmcnt(0)" ::: "memory");
}

__device__ __forceinline__ void s5_prep(KArgs ap_, int l, int g, int q, LAS unsigned char* lds, int tid) {
    KArgs ap = ap_; asm volatile("" : "+s"(ap)); KArgsRef a = *ap; tid = opq(tid);
    LAS float* AR = (LAS float*)lds;
    LAS float* AI = AR + 17 * 64;
    LAS float* BBR = AI + 17 * 64;
    LAS float* BBI = BBR + 1024;
    LAS float* CR = BBI + 1024;
    LAS float* CI = CR + 1024;
    LAS float* KT = CI + 1024;
    unsigned char* ws = a.ws;
    bf16_t* TM = (bf16_t*)(ws + WS_TM) + (size_t)g * 384 * 256;
    bf16_t* M3 = (bf16_t*)(ws + WS_M3) + (size_t)g * 256 * 128;
    float* A16 = (float*)(ws + WS_A16) + g * 128;
    const float* dsk = a.in[29] + l * 512 + 16 * g;
    const float step = expf(a.in[24][l * 32 + g]);
    const float* lre = a.in[22] + (size_t)(l * 32 + g) * 64; const float* lim = a.in[23] + (size_t)(l * 32 + g) * 64;
    for (int e = tid; e < 17 * 64; e += NTHR) { const int t = e >> 6, n = e & 63; const float lr = lre[n], li = lim[n];
        const float mag = expf(lr * step * (float)t), ang = li * step * (float)t; AR[e] = mag * cosf(ang); AI[e] = mag * sinf(ang); }
    for (int e = tid; e < 1024; e += NTHR) { CR[e] = a.in[27][(size_t)(l * 32 + g) * 1024 + e]; CI[e] = a.in[28][(size_t)(l * 32 + g) * 1024 + e]; }
    __syncthreads();
    for (int e = tid; e < 1024; e += NTHR) { const int n = e >> 4, i = e & 15; const float lr = lre[n], li = lim[n];
        const float abr = AR[64 + n], abi = AI[64 + n], den = lr * lr + li * li;
        const float cre = ((abr - 1.f) * lr + abi * li) / den, cim = (abi * lr - (abr - 1.f) * li) / den;
        const float br = a.in[25][((size_t)(l * 32 + g) * 64 + n) * 16 + i], bi = a.in[26][((size_t)(l * 32 + g) * 64 + n) * 16 + i];
        BBR[e] = cre * br - cim * bi; BBI[e] = cre * bi + cim * br; }
    if (q == 0 && tid < 64) { A16[2 * tid] = AR[16 * 64 + tid]; A16[2 * tid + 1] = AI[16 * 64 + tid]; }
    __syncthreads();
    for (int e2 = tid; e2 < 1024; e2 += NTHR) { const int e = 1024 * q + e2; const int t = e >> 8, o = (e >> 4) & 15, i = e & 15; float s = 0.f;
        for (int n = 0; n < 64; ++n) { const float cr = CR[o * 64 + n], ci = CI[o * 64 + n], pr = AR[t * 64 + n], pi = AI[t * 64 + n];
            const float xr = cr * pr - ci * pi, xi = cr * pi + ci * pr; s += xr * BBR[n * 16 + i] - xi * BBI[n * 16 + i]; }
        if (t == 0 && o == i) s += dsk[o];
        KT[e] = s; }
    __syncthreads();
    for (int e = tid; e < 256 * 128; e += NTHR) { const int nn = e >> 7, kk = 2 * (e & 127), t = nn >> 4, o = nn & 15, j = kk >> 4, i = kk & 15, d = t - j;
        if (d >= 0 ? (d >> 2) == q : q == 0) { float v0 = 0.f, v1 = 0.f; if (d >= 0) { v0 = KT[(d * 16 + o) * 16 + i]; v1 = KT[(d * 16 + o) * 16 + i + 1]; }
            *(unsigned*)(TM + (size_t)nn * 256 + kk) = pk2(v0, v1); } }
    for (int e = tid; e < 32 * 128; e += NTHR) { const int rr = 32 * q + (e >> 7), kk = 2 * (e & 127), n = rr >> 1, ri = rr & 1, j = kk >> 4, i = kk & 15;
        const float pr = AR[(15 - j) * 64 + n], pi = AI[(15 - j) * 64 + n];
        float v[2];
#pragma unroll
        for (int qq = 0; qq < 2; ++qq) { const float br = BBR[n * 16 + i + qq], bi = BBI[n * 16 + i + qq]; v[qq] = ri == 0 ? pr * br - pi * bi : pr * bi + pi * br; }
        *(unsigned*)(TM + (size_t)(256 + rr) * 256 + kk) = pk2(v[0], v[1]); }
    for (int e = tid; e < 64 * 64; e += NTHR) { const int nn = 64 * q + (e >> 6), n = e & 63, t = nn >> 4, o = nn & 15;
        const float cr = CR[o * 64 + n], ci = CI[o * 64 + n], pr = AR[(t + 1) * 64 + n], pi = AI[(t + 1) * 64 + n];
        *(unsigned*)(M3 + (size_t)nn * 128 + 2 * n) = pk2(cr * pr - ci * pi, -(cr * pi + ci * pr)); }
    __syncthreads();
}

template <bool WITH_DT, bool IN_BF> __device__ __forceinline__ void rmsnorm_rows(const void* X, const float* gamma, bf16_t* H, float* DT, const LAS float* wdt, int gw, int NGW, int lane) {
    lane = opq(lane);
    f32x4 g[4];
#pragma unroll
    for (int j = 0; j < 4; ++j) g[j] = *(const f32x4*)(gamma + 4 * lane + 256 * j);
    for (int m = gw; m < MTOK; m += 4 * NGW) {
        f32x4 v[4][4]; float s[4];
#pragma unroll
        for (int r = 0; r < 4; ++r) { const size_t xo = (size_t)(m + r * NGW) * DM + 4 * lane; s[r] = 0.f;
#pragma unroll
            for (int j = 0; j < 4; ++j) {
                if (IN_BF) { const u32x2 w = *(const u32x2*)((const bf16_t*)X + xo + 256 * j); v[r][j] = (f32x4){bf_lo(w.x), bf_hi(w.x), bf_lo(w.y), bf_hi(w.y)}; }
                else v[r][j] = *(const f32x4*)((const float*)X + xo + 256 * j);
                s[r] += (v[r][j].x * v[r][j].x + v[r][j].y * v[r][j].y) + (v[r][j].z * v[r][j].z + v[r][j].w * v[r][j].w); } }
#pragma unroll
        for (int r = 0; r < 4; ++r) {
            const float rinv = 1.f / sqrtf(wave_sum(s[r]) * (1.f / DM) + 1e-6f);
            bf16_t* hr = H + (size_t)(m + r * NGW) * DM + 4 * lane;
#pragma unroll
            for (int j = 0; j < 4; ++j) { v[r][j] = v[r][j] * rinv * g[j]; u32x2 o; o.x = pk2(v[r][j].x, v[r][j].y); o.y = pk2(v[r][j].z, v[r][j].w); *(u32x2*)(hr + 256 * j) = o; }
            if (WITH_DT) {
                float d[8];
#pragma unroll
                for (int q = 0; q < 8; ++q) { d[q] = 0.f;
#pragma unroll
                    for (int j = 0; j < 4; ++j) { const f32x4 w = *(const LAS f32x4*)(wdt + q * 1024 + 4 * lane + 256 * j); d[q] += (v[r][j].x * w.x + v[r][j].y * w.y) + (v[r][j].z * w.z + v[r][j].w * w.w); } }
#pragma unroll
                for (int q = 0; q < 8; ++q) d[q] = wave_sum(d[q]);
                if (lane == 0) { *(f32x4*)(DT + (size_t)(m + r * NGW) * 8) = (f32x4){d[0], d[1], d[2], d[3]}; *(f32x4*)(DT + (size_t)(m + r * NGW) * 8 + 4) = (f32x4){d[4], d[5], d[6], d[7]}; }
            }
        }
    }
}

__device__ __forceinline__ void phase_prep(KArgs ap_, int l, const void* X, LAS unsigned char* lds, int tid, int lane, int wave) {
    KArgs ap = ap_; asm volatile("" : "+s"(ap)); KArgsRef a = *ap; tid = opq(tid); lane = opq(lane);
    unsigned char* ws = a.ws;
    if ((int)blockIdx.x < 128) s5_prep(ap, l, blockIdx.x >> 2, blockIdx.x & 3, lds, tid);
    LAS float* scr = (LAS float*)(lds + wave * 8448);
    const int gw = blockIdx.x * NWAVES + wave, NGW = gridDim.x * NWAVES;
    const float* w_in = a.in[2] + (size_t)l * DM * IN_COLS;
    constexpr int I_WIN = 16 * 120, I_WG = 16 * 96, I_P = 8 * 32, I_GLU = 8 * 16, I_WOUT = 16 * 32, I_FIN = 16 * 176, I_FOUT = 44 * 32, I_UP = 16, I_GUP = 32;
    constexpr int NITEMS = I_WIN + I_WG + 3 * I_P + I_GLU + I_WOUT + I_FIN + I_FOUT + 2 * I_UP + I_GUP;
    const int NGWT = 3 * 128 * NWAVES;
    const int gwt = (int)blockIdx.x >= 128 ? ((int)blockIdx.x - 128) * NWAVES + wave : 2 * 128 * NWAVES + (int)blockIdx.x * NWAVES + wave;
    const int nslot = (int)blockIdx.x >= 128 ? 2 : 1;
    for (int sl = 0; sl < nslot; ++sl)
    for (int it = gwt + sl * 128 * NWAVES; it < NITEMS; it += NGWT) {
        int r = it;
        if (r < I_WIN) { const int kb = r / 120, nb = r % 120, n0 = 32 * nb, c0 = n0 < 3328 ? n0 : n0 + 8; tr_item(w_in, IN_COLS, 64 * kb, c0, (bf16_t*)(ws + WS_WIN), 1024, n0, scr, lane); continue; } r -= I_WIN;
        if (r < I_WG) { const int kb = r / 96, nb = r % 96, n0 = 32 * nb; tr_item(w_in, IN_COLS, 64 * kb, 3848 + n0, (bf16_t*)(ws + WS_WG), 1024, n0, scr, lane); continue; } r -= I_WG;
        if (r < I_P) { tr_item(a.in[14] + (size_t)l * 512 * 1024, 1024, 64 * (r / 32), 32 * (r % 32), (bf16_t*)(ws + WS_PA), 512, 32 * (r % 32), scr, lane); continue; } r -= I_P;
        if (r < I_P) { tr_item(a.in[21] + (size_t)l * 512 * 1024, 1024, 64 * (r / 32), 32 * (r % 32), (bf16_t*)(ws + WS_PB), 512, 32 * (r % 32), scr, lane); continue; } r -= I_P;
        if (r < I_P) { tr_item(a.in[32] + (size_t)l * 512 * 1024, 1024, 64 * (r / 32), 32 * (r % 32), (bf16_t*)(ws + WS_PC), 512, 32 * (r % 32), scr, lane); continue; } r -= I_P;
        if (r < I_GLU) { tr_item(a.in[30] + (size_t)l * 512 * 512, 512, 64 * (r / 16), 32 * (r % 16), (bf16_t*)(ws + WS_GLU), 512, 32 * (r % 16), scr, lane); continue; } r -= I_GLU;
        if (r < I_WOUT) { tr_item(a.in[33] + (size_t)l * 1024 * 1024, 1024, 64 * (r / 32), 32 * (r % 32), (bf16_t*)(ws + WS_WOUT), 1024, 32 * (r % 32), scr, lane); continue; } r -= I_WOUT;
        if (r < I_FIN) { const int kb = r / 176, nb = r % 176, c0 = ((nb >> 2) & 1) * FFH + 128 * (nb >> 3) + 32 * (nb & 3);
            tr_item(a.in[35] + (size_t)l * 1024 * 2 * FFH, 2 * FFH, 64 * kb, c0, (bf16_t*)(ws + WS_FIN), 1024, 32 * nb, scr, lane); continue; } r -= I_FIN;
        if (r < I_FOUT) { tr_item(a.in[36] + (size_t)l * FFH * 1024, 1024, 64 * (r / 32), 32 * (r % 32), (bf16_t*)(ws + WS_FOUT), FFH, 32 * (r % 32), scr, lane); continue; } r -= I_FOUT;
        if (r < I_UP) { tr_item(a.in[5] + (size_t)l * 64 * 512, 512, 0, 32 * r, (bf16_t*)(ws + WS_WUP), 64, 32 * r, scr, lane); continue; } r -= I_UP;
        if (r < I_UP) { tr_item(a.in[7] + (size_t)l * 64 * 512, 512, 0, 32 * r, (bf16_t*)(ws + WS_AUP), 64, 32 * r, scr, lane); continue; } r -= I_UP;
        tr_item(a.in[8] + (size_t)l * 128 * 512, 512, 64 * (r / 16), 32 * (r % 16), (bf16_t*)(ws + WS_GUP), 128, 32 * (r % 16), scr, lane);
    }
    __syncthreads();
    LAS float* wdt = (LAS float*)lds;
    for (int e = tid; e < 8192; e += NTHR) { const int k = e >> 3, q = e & 7; wdt[q * 1024 + k] = w_in[(size_t)k * IN_COLS + 3328 + q]; }
    __syncthreads();
    if (l == 0) rmsnorm_rows<true, false>(X, a.in[1] + l * DM, (bf16_t*)(ws + WS_H), (float*)(ws + WS_DT), wdt, gw, NGW, lane);
    else rmsnorm_rows<true, true>(X, a.in[1] + l * DM, (bf16_t*)(ws + WS_H), (float*)(ws + WS_DT), wdt, gw, NGW, lane);
    __syncthreads();
}

constexpr int R_CT = 16, R_NCH = SEQ / R_CT;
constexpr int R_BW = 0, R_BA = 9216, R_BG = 18432, R_AW = 35840, R_AA = 38144, R_AG = 40448, R_VEC2 = 44800, R_VEC3 = 85760, R_BON = 110336, R_INV = 111104, R_OB = 111168;
struct StepV { f32x4 n0, n1, w0, w1, b0, b1, k0, k1, r0, r1; f32x2 vv; };
__device__ __forceinline__ StepV rw_load(const LAS float* v2, const LAS float* vvb, int t, int jj, int rp) {
    StepV s; const LAS float* p = v2 + t * 64 + 8 * jj;
    s.n0 = *(const LAS f32x4*)(p); s.n1 = *(const LAS f32x4*)(p + 4);
    s.w0 = *(const LAS f32x4*)(p + 1024); s.w1 = *(const LAS f32x4*)(p + 1028);
    s.b0 = *(const LAS f32x4*)(p + 2048); s.b1 = *(const LAS f32x4*)(p + 2052);
    s.k0 = *(const LAS f32x4*)(p + 3072); s.k1 = *(const LAS f32x4*)(p + 3076);
    s.r0 = *(const LAS f32x4*)(p + 4096); s.r1 = *(const LAS f32x4*)(p + 4100);
    s.vv = *(const LAS f32x2*)(vvb + t * 64 + 2 * rp);
    return s;
}
template <int CTRL> __device__ __forceinline__ float dppb(float x) { return __builtin_bit_cast(float, __builtin_amdgcn_update_dpp(0, __builtin_bit_cast(int, x), CTRL, 0xf, 0xf, true)); }
__device__ __forceinline__ float red8b(float x) { x += dppb<0xB1>(x); x += dppb<0x4E>(x); x += dppb<0x141>(x); return x; }
__device__ __forceinline__ void rw_step(f32x2 (&S)[8], const StepV& s, LAS float* ob, int t, int jj, int rp) {
    const f32x2 nA[4] = {{s.n0.x, s.n0.y}, {s.n0.z, s.n0.w}, {s.n1.x, s.n1.y}, {s.n1.z, s.n1.w}};
    const f32x2 wA[4] = {{s.w0.x, s.w0.y}, {s.w0.z, s.w0.w}, {s.w1.x, s.w1.y}, {s.w1.z, s.w1.w}};
    const f32x2 bA[4] = {{s.b0.x, s.b0.y}, {s.b0.z, s.b0.w}, {s.b1.x, s.b1.y}, {s.b1.z, s.b1.w}};
    const f32x2 kA[4] = {{s.k0.x, s.k0.y}, {s.k0.z, s.k0.w}, {s.k1.x, s.k1.y}, {s.k1.z, s.k1.w}};
    const f32x2 rA[4] = {{s.r0.x, s.r0.y}, {s.r0.z, s.r0.w}, {s.r1.x, s.r1.y}, {s.r1.z, s.r1.w}};
    f32x2 a0 = S[0] * nA[0], a1 = S[4] * nA[0];
#pragma unroll
    for (int i = 1; i < 4; ++i) { a0 += S[i] * nA[i]; a1 += S[4 + i] * nA[i]; }
    float sa0 = red8b(a0.x + a0.y), sa1 = red8b(a1.x + a1.y);
    const float v0 = s.vv.x, v1 = s.vv.y;
#pragma unroll
    for (int i = 0; i < 4; ++i) { S[i] = S[i] * wA[i] + (bA[i] * sa0 + kA[i] * v0); S[4 + i] = S[4 + i] * wA[i] + (bA[i] * sa1 + kA[i] * v1); }
    f32x2 o0 = S[0] * rA[0], o1 = S[4] * rA[0];
#pragma unroll
    for (int i = 1; i < 4; ++i) { o0 += S[i] * rA[i]; o1 += S[4 + i] * rA[i]; }
    f32x2 o; o.x = red8b(o0.x + o0.y); o.y = red8b(o1.x + o1.y);
    if (jj == 0) *(LAS f32x2*)(ob + t * 64 + 2 * rp) = o;
}
__device__ __forceinline__ void rwkv_unit(KArgs ap_, int l, int b, int h, LAS unsigned char* lds, int tid, int lane, int wave) {
    KArgs ap = ap_; asm volatile("" : "+s"(ap)); KArgsRef a = *ap; tid = opq(tid); lane = opq(lane);
    unsigned char* ws = a.ws;
    const bf16_t* proj = (const bf16_t*)(ws + WS_PROJ);
    bf16_t* Ya = (bf16_t*)(ws + WS_YA);
    LAS bf16_t* BW = (LAS bf16_t*)(lds + R_BW); LAS bf16_t* BA = (LAS bf16_t*)(lds + R_BA); LAS bf16_t* BG = (LAS bf16_t*)(lds + R_BG);
    LAS bf16_t* AW = (LAS bf16_t*)(lds + R_AW); LAS bf16_t* AA = (LAS bf16_t*)(lds + R_AA); LAS bf16_t* AG = (LAS bf16_t*)(lds + R_AG);
    LAS float* VEC2 = (LAS float*)(lds + R_VEC2);
    LAS float* VEC3 = (LAS float*)(lds + R_VEC3);
    LAS float* BONP = (LAS float*)(lds + R_BON);
    LAS float* INV = (LAS float*)(lds + R_INV);
    LAS float* OBB = (LAS float*)(lds + R_OB);
    const float* mu = a.in[3] + l * 1792;
    const float* w0 = a.in[4] + l * 512 + 64 * h; const float* a0 = a.in[6] + l * 512 + 64 * h;
    const float* k_k = a.in[9] + l * 512 + 64 * h; const float* k_a = a.in[10] + l * 512 + 64 * h; const float* r_k = a.in[11] + l * 512 + 64 * h;
    const float* ln_g = a.in[12] + l * 512 + 64 * h; const float* ln_b = a.in[13] + l * 512 + 64 * h;
    { const bf16_t* wup = (const bf16_t*)(ws + WS_WUP) + (size_t)64 * h * 64; const bf16_t* aup = (const bf16_t*)(ws + WS_AUP) + (size_t)64 * h * 64; const bf16_t* gup = (const bf16_t*)(ws + WS_GUP) + (size_t)64 * h * 128;
      { const int n = tid >> 3, c = tid & 7; *(LAS u32x4*)(BW + n * 72 + 8 * c) = *(const u32x4*)(wup + n * 64 + 8 * c); *(LAS u32x4*)(BA + n * 72 + 8 * c) = *(const u32x4*)(aup + n * 64 + 8 * c); }
      for (int e = tid; e < 1024; e += NTHR) { const int n = e >> 4, c = e & 15; *(LAS u32x4*)(BG + n * 136 + 8 * c) = *(const u32x4*)(gup + n * 128 + 8 * c); } }
    const bool is_scan = wave < 4;
    const size_t rowbase = (size_t)b * SEQ;
    f32x2 S[8];
#pragma unroll
    for (int i = 0; i < 8; ++i) S[i] = (f32x2){0.f, 0.f};
    const int rp = (tid >> 3) & 31, jj = tid & 7;
    const int pt = tid & 255, pw = wave & 3;
    u32x4 RC[4], RP[4];
#pragma unroll
    for (int i = 0; i < 4; ++i) { RC[i] = (u32x4){0u, 0u, 0u, 0u}; RP[i] = (u32x4){0u, 0u, 0u, 0u}; }
    __syncthreads();

#define RW_LD(IDX, KIND, tok, colv, lcv, MU, DSTF, DSTB, LDB) do { \
    const int t_ = (cn_) * R_CT + (tok); const bf16_t* pr_ = proj + (rowbase + t_) * NPROJ + (colv); \
    RC[IDX] = *(const u32x4*)pr_; RP[IDX] = t_ > 0 ? *(const u32x4*)(pr_ - NPROJ) : (u32x4){0u, 0u, 0u, 0u}; } while (0)
#define RW_PAIR(IDX, KIND, tok, colv, lcv, MU, DSTF, DSTB, LDB) do { \
    float cur_[8], prv_[8], v_[8]; unpack8(RC[IDX], cur_); unpack8(RP[IDX], prv_); \
    { const f32x4 m0_ = *(const f32x4*)(mu + (colv)), m1_ = *(const f32x4*)(mu + (colv) + 4); \
      _Pragma("unroll") for (int e = 0; e < 4; ++e) { v_[e] = cur_[e] + (prv_[e] - cur_[e]) * m0_[e]; v_[4 + e] = cur_[4 + e] + (prv_[4 + e] - cur_[4 + e]) * m1_[e]; } } \
    if (KIND <= 2) { LAS float* d_ = (DSTF) + (tok) * 64 + (lcv); *(LAS f32x4*)d_ = (f32x4){v_[0], v_[1], v_[2], v_[3]}; *(LAS f32x4*)(d_ + 4) = (f32x4){v_[4], v_[5], v_[6], v_[7]}; \
        if (KIND == 1) { const f32x4 k0_ = *(const f32x4*)(k_k + (lcv)), k1_ = *(const f32x4*)(k_k + (lcv) + 4); float q_ = 0.f; _Pragma("unroll") for (int e = 0; e < 4; ++e) { const float x_ = v_[e] * k0_[e], y_ = v_[4 + e] * k1_[e]; q_ += x_ * x_ + y_ * y_; } q_ = red8b(q_); if (((lcv) >> 3) == 0) INV[tok] = __builtin_amdgcn_rsqf(fmaxf(q_, 1e-24f)); } } \
    else { if (KIND == 3) { _Pragma("unroll") for (int e = 0; e < 8; ++e) v_[e] = ftanh(v_[e]); } \
        if (KIND == 5) { _Pragma("unroll") for (int e = 0; e < 8; ++e) v_[e] = sigm(v_[e]); } \
        *(LAS u32x4*)((DSTB) + (tok) * (LDB) + (lcv)) = pack8(v_); } } while (0)
#define RW_FORPAIRS(OP) do { const int ln = opq(lane); \
    if (pw == 0) { _Pragma("unroll") for (int i = 0; i < 2; ++i) { const int tok = (ln >> 3) + 8 * i, lc = 8 * (ln & 7); \
            OP(2 * i, 3, tok, P_WD + lc, lc, muA, v2, AW, 72); OP(2 * i + 1, 4, tok, P_AD + lc, lc, muB, v2, AA, 72); } } \
    else if (pw == 1) { _Pragma("unroll") for (int i = 0; i < 2; ++i) { const int tok = (ln >> 4) + 4 * i, lc = 8 * (ln & 15), tok2 = (ln >> 3) + 8 * i, lc2 = 8 * (ln & 7); \
            OP(2 * i, 5, tok, P_GD + lc, lc, muA, v2, AG, 136); OP(2 * i + 1, 0, tok2, P_R + 64 * h + lc2, lc2, muB, v2 + 4096, AW, 72); } } \
    else if (pw == 2) { _Pragma("unroll") for (int i = 0; i < 2; ++i) { const int tok = 8 + (ln >> 4) + 4 * i, lc = 8 * (ln & 15), tok2 = (ln >> 3) + 8 * i, lc2 = 8 * (ln & 7); \
            OP(2 * i, 5, tok, P_GD + lc, lc, muA, v2, AG, 136); OP(2 * i + 1, 2, tok2, P_V + 64 * h + lc2, lc2, muB, v3, AW, 72); } } \
    else { _Pragma("unroll") for (int i = 0; i < 2; ++i) { const int tok = (ln >> 3) + 8 * i, lc = 8 * (ln & 7); \
            OP(i, 1, tok, P_K + 64 * h + lc, lc, muA, v2 + 3072, AW, 72); } } \
    } while (0)
#define RW_LOAD(cn) do { const int cn_ = (cn); LAS float* v2 = nullptr; LAS float* v3 = nullptr; (void)v2; (void)v3; RW_FORPAIRS(RW_LD); } while (0)
#define RW_PREP1(cn) do { const int cn_ = (cn); (void)cn_; \
    LAS float* v2 = VEC2 + (cn_ & 1) * 5120; LAS float* v3 = VEC3 + (cn_ % 3) * 2048; RW_FORPAIRS(RW_PAIR); } while (0)

#define RW_PREP2(cn) do { const int ln2 = opq(lane); const int r16 = ln2 & 15, q4 = ln2 >> 4, kq = 8 * q4, nn = 16 * pw + r16; \
    const float w0n = w0[nn], a0n = a0[nn], kkn = k_k[nn], kan = k_a[nn], rkn = r_k[nn]; \
    LAS float* v2 = VEC2 + ((cn) & 1) * 5120; LAS float* v3 = VEC3 + ((cn) % 3) * 2048; LAS float* bp = BONP + ((cn) % 3) * 64; \
    const f32x4 z4_ = {0.f, 0.f, 0.f, 0.f}; \
    f32x4 cw = MFMA16(ldsfrag(AW, r16, 72, kq), ldsfrag(BW, 16 * pw + r16, 72, kq), z4_); cw = MFMA16(ldsfrag(AW, r16, 72, 32 + kq), ldsfrag(BW, 16 * pw + r16, 72, 32 + kq), cw); \
    f32x4 ca = MFMA16(ldsfrag(AA, r16, 72, kq), ldsfrag(BA, 16 * pw + r16, 72, kq), z4_); ca = MFMA16(ldsfrag(AA, r16, 72, 32 + kq), ldsfrag(BA, 16 * pw + r16, 72, 32 + kq), ca); \
    f32x4 cgt = MFMA16(ldsfrag(AG, r16, 136, kq), ldsfrag(BG, 16 * pw + r16, 136, kq), z4_); \
    _Pragma("unroll") for (int ks = 1; ks < 4; ++ks) cgt = MFMA16(ldsfrag(AG, r16, 136, 32 * ks + kq), ldsfrag(BG, 16 * pw + r16, 136, 32 * ks + kq), cgt); \
    _Pragma("unroll") for (int j = 0; j < 4; ++j) { const int tok = 4 * q4 + j; \
        const float wv = __expf(-0.6065306597f * sigm(w0n + cw[j])); const float av = sigm(a0n + ca[j]); \
        const float kr = v2[3072 + tok * 64 + nn], rr = v2[4096 + tok * 64 + nn], inv = INV[tok]; \
        const float kk = kr * kkn * inv, kp = kr * (1.f + (av - 1.f) * kan); \
        v2[tok * 64 + nn] = -kk; v2[1024 + tok * 64 + nn] = wv; v2[2048 + tok * 64 + nn] = kk * av; v2[3072 + tok * 64 + nn] = kp; \
        v3[1024 + tok * 64 + nn] = cgt[j]; \
        float bs = rr * kp * rkn; bs = red16(bs); if (r16 == 0) bp[tok * 4 + pw] = bs; } \
    } while (0)

#define RW_FIN(cf) do { \
    const LAS float* ob = OBB + ((cf) & 1) * 1024; const LAS float* v3 = VEC3 + ((cf) % 3) * 2048; const LAS float* bp = BONP + ((cf) % 3) * 64; \
    const int pt_ = opq(pt); const int tok = pt_ >> 4, sub = pt_ & 15, n0 = 4 * sub; \
    const f32x4 o = *(const LAS f32x4*)(ob + tok * 64 + n0); \
    float s = (o.x + o.y) + (o.z + o.w); s = red16(s); \
    const float mean = s * (1.f / 64.f); const f32x4 d = o - mean; \
    float q = (d.x * d.x + d.y * d.y) + (d.z * d.z + d.w * d.w); q = red16(q); \
    const float rstd = __builtin_amdgcn_rsqf(q * (1.f / 64.f) + 64e-5f); \
    const f32x4 lg = *(const f32x4*)(ln_g + n0), lb = *(const f32x4*)(ln_b + n0); \
    const f32x4 vv = *(const LAS f32x4*)(v3 + tok * 64 + n0), gg = *(const LAS f32x4*)(v3 + 1024 + tok * 64 + n0); \
    const f32x4 bq = *(const LAS f32x4*)(bp + tok * 4); const float bon = (bq.x + bq.y) + (bq.z + bq.w); \
    const f32x4 y = (d * rstd * lg + lb + vv * bon) * gg; \
    u32x2 w; w.x = pk2(y.x, y.y); w.y = pk2(y.z, y.w); \
    *(u32x2*)(Ya + (rowbase + (cf) * R_CT + tok) * 512 + 64 * h + n0) = w; } while (0)

#define RW_SCAN8(c, t0) do { \
    const int a2_ = opq(R_VEC2 + ((c) & 1) * 20480 + 32 * jj), a3_ = opq(R_VEC3 + ((c) % 3) * 8192 + 8 * rp), ao_ = opq(R_OB + ((c) & 1) * 4096 + 8 * rp); \
    const LAS float* v2 = (const LAS float*)(lds + a2_); const LAS float* vvb = (const LAS float*)(lds + a3_); LAS float* ob = (LAS float*)(lds + ao_); \
    StepV cur = rw_load(v2, vvb, (t0), 0, 0); \
    _Pragma("unroll") for (int i = 0; i < 8; ++i) { StepV nxt; if (i < 7) nxt = rw_load(v2, vvb, (t0) + i + 1, 0, 0); \
        rw_step(S, cur, ob, (t0) + i, jj, 0); if (i < 7) cur = nxt; } } while (0)

    if (!is_scan) { RW_LOAD(0); RW_PREP1(0); RW_LOAD(1); }
    __syncthreads();
    if (!is_scan) RW_PREP2(0);
    __syncthreads();
#pragma unroll 1
    for (int c = 0; c < R_NCH; ++c) {
        if (is_scan) { RW_SCAN8(c, 0); } else { if (c + 1 < R_NCH) RW_PREP1(c + 1); if (c + 2 < R_NCH) RW_LOAD(c + 2); }
        __syncthreads();
        if (is_scan) { RW_SCAN8(c, 8); } else { if (c + 1 < R_NCH) RW_PREP2(c + 1); if (c >= 1) RW_FIN(c - 1); }
        __syncthreads();
    }
    if (!is_scan) RW_FIN(R_NCH - 1);
    __syncthreads();
#undef RW_PREP1
#undef RW_LOAD
#undef RW_LD
#undef RW_PAIR
#undef RW_FORPAIRS
#undef RW_PREP2
#undef RW_FIN
#undef RW_SCAN8
}

constexpr int S_LD = 136;
constexpr int S_CS = 0, S_BS = 34816, S_BT = 69632, S_XT = 104448, S_SB = 121856, S_ACS = 139264, S_DTV = 139776;
__device__ __forceinline__ void ssd_unit(KArgs ap_, int l, int b, int h, LAS unsigned char* lds, int tid, int lane, int wave) {
    KArgs ap = ap_; asm volatile("" : "+s"(ap)); KArgsRef a = *ap; tid = opq(tid); lane = opq(lane);
    unsigned char* ws = a.ws;
    const bf16_t* proj = (const bf16_t*)(ws + WS_PROJ);
    const float* dtraw = (const float*)(ws + WS_DT);
    bf16_t* Yb = (bf16_t*)(ws + WS_YB);
    LAS bf16_t* Cs = (LAS bf16_t*)(lds + S_CS); LAS bf16_t* Bs = (LAS bf16_t*)(lds + S_BS); LAS bf16_t* BT = (LAS bf16_t*)(lds + S_BT);
    LAS bf16_t* XT = (LAS bf16_t*)(lds + S_XT); LAS bf16_t* SB = (LAS bf16_t*)(lds + S_SB);
    LAS float* ACS = (LAS float*)(lds + S_ACS); LAS float* DTV = (LAS float*)(lds + S_DTV);
    const int g = h >> 2;
    const float* cw = a.in[15] + (size_t)l * 4 * 1024; const float* cb = a.in[16] + l * 1024;
    const float dtb = a.in[17][l * 8 + h], Ah = -expf(a.in[18][l * 8 + h]), Dh = a.in[19][l * 8 + h];
    const size_t rowbase = (size_t)b * SEQ;
    const int r16 = lane & 15, q4 = lane >> 4, kq = 8 * q4;
    f32x4 st[4];
#pragma unroll
    for (int i = 0; i < 4; ++i) st[i] = (f32x4){0.f, 0.f, 0.f, 0.f};
    for (int e = tid; e < 64 * S_LD / 2; e += NTHR) ((LAS unsigned*)SB)[e] = 0u;
    __syncthreads();
    for (int t0 = 0; t0 < SEQ; t0 += 128) {
        if (tid < 128) DTV[tid] = softplusf(dtraw[(rowbase + t0 + tid) * 8 + h] + dtb);
        __syncthreads();
        if (wave == 0) { const float a0 = DTV[2 * lane] * Ah, a1 = DTV[2 * lane + 1] * Ah; float s = a0 + a1;
#pragma unroll
            for (int o = 1; o < 64; o <<= 1) { const float t = __shfl_up(s, o); if (lane >= o) s += t; }
            ACS[2 * lane + 1] = s; ACS[2 * lane] = s - a1; }
        __syncthreads();
        const float acsL = ACS[127];
        for (int item = tid; item < 640; item += NTHR) {
            const int tg = item / 40, vec = item % 40, l0 = 8 * tg;
            int col, kind, lc;
            if (vec < 8) { kind = 0; lc = 8 * vec; col = P_XS + 64 * h + lc; }
            else if (vec < 24) { kind = 1; lc = 8 * (vec - 8); col = P_B + 128 * g + lc; }
            else { kind = 2; lc = 8 * (vec - 24); col = P_C + 128 * g + lc; }
            const int cc = col - P_XS;
            u32x4 in[11];
#pragma unroll
            for (int i = 0; i < 11; ++i) { const int t = t0 + l0 - 3 + i; in[i] = t >= 0 ? *(const u32x4*)(proj + (rowbase + t) * NPROJ + col) : (u32x4){0u, 0u, 0u, 0u}; }
            float wj[4][8], bias[8];
#pragma unroll
            for (int j = 0; j < 4; ++j) { const f32x4 x0 = *(const f32x4*)(cw + j * 1024 + cc), x1 = *(const f32x4*)(cw + j * 1024 + cc + 4);
                wj[j][0] = x0.x; wj[j][1] = x0.y; wj[j][2] = x0.z; wj[j][3] = x0.w; wj[j][4] = x1.x; wj[j][5] = x1.y; wj[j][6] = x1.z; wj[j][7] = x1.w; }
            { const f32x4 x0 = *(const f32x4*)(cb + cc), x1 = *(const f32x4*)(cb + cc + 4); bias[0] = x0.x; bias[1] = x0.y; bias[2] = x0.z; bias[3] = x0.w; bias[4] = x1.x; bias[5] = x1.y; bias[6] = x1.z; bias[7] = x1.w; }
            float out[8][8];
#pragma unroll
            for (int tt = 0; tt < 8; ++tt)
#pragma unroll
                for (int e = 0; e < 8; ++e) out[tt][e] = bias[e];
#pragma unroll
            for (int i = 0; i < 11; ++i) { float x[8]; unpack8(in[i], x);
#pragma unroll
                for (int j = 0; j < 4; ++j) { const int tt = i - j;
                    if (tt >= 0 && tt < 8) {
#pragma unroll
                        for (int e = 0; e < 8; ++e) out[tt][e] += wj[j][e] * x[e]; } } }
#pragma unroll
            for (int tt = 0; tt < 8; ++tt)
#pragma unroll
                for (int e = 0; e < 8; ++e) out[tt][e] = out[tt][e] * sigm(out[tt][e]);
            if (kind == 0) {
                float dtl[8];
#pragma unroll
                for (int tt = 0; tt < 8; ++tt) dtl[tt] = DTV[l0 + tt];
#pragma unroll
                for (int e = 0; e < 8; ++e) { float c[8];
#pragma unroll
                    for (int tt = 0; tt < 8; ++tt) c[tt] = out[tt][e] * dtl[tt];
                    *(LAS u32x4*)(XT + (lc + e) * S_LD + l0) = pack8(c); }
            } else if (kind == 1) {
                float dec[8];
#pragma unroll
                for (int tt = 0; tt < 8; ++tt) dec[tt] = __expf(acsL - ACS[l0 + tt]);
#pragma unroll
                for (int tt = 0; tt < 8; ++tt) *(LAS u32x4*)(Bs + (l0 + tt) * S_LD + lc) = pack8(out[tt]);
#pragma unroll
                for (int e = 0; e < 8; ++e) { float c[8];
#pragma unroll
                    for (int tt = 0; tt < 8; ++tt) c[tt] = out[tt][e] * dec[tt];
                    *(LAS u32x4*)(BT + (lc + e) * S_LD + l0) = pack8(c); }
            } else {
#pragma unroll
                for (int tt = 0; tt < 8; ++tt) *(LAS u32x4*)(Cs + (l0 + tt) * S_LD + lc) = pack8(out[tt]);
            }
        }
        __syncthreads();
        f32x4 sc[8];
#pragma unroll
        for (int i = 0; i < 8; ++i) sc[i] = (f32x4){0.f, 0.f, 0.f, 0.f};
#pragma unroll
        for (int ks = 0; ks < 4; ++ks) { const bf16x8 af = ldsfrag(Cs, 16 * wave + r16, S_LD, 32 * ks + kq);
#pragma unroll
            for (int s = 0; s < 8; ++s) sc[s] = MFMA16(af, ldsfrag(Bs, 16 * s + r16, S_LD, 32 * ks + kq), sc[s]); }
        __syncthreads();
        {
            float al[4], dl[4];
#pragma unroll
            for (int j = 0; j < 4; ++j) { al[j] = ACS[16 * wave + 4 * q4 + j]; dl[j] = Dh / DTV[16 * wave + 4 * q4 + j]; }
#pragma unroll
            for (int s = 0; s < 8; ++s) { const int sidx = 16 * s + r16; const float as = ACS[sidx];
#pragma unroll
                for (int j = 0; j < 4; ++j) { const int lidx = 16 * wave + 4 * q4 + j;
                    float v = sidx <= lidx ? sc[s][j] * __expf(al[j] - as) : 0.f; if (sidx == lidx) v += dl[j];
                    Bs[lidx * S_LD + sidx] = (bf16_t)f2bf(v); } }
        }
        __syncthreads();
        {
            f32x4 yd[4], yo[4];
#pragma unroll
            for (int i = 0; i < 4; ++i) { yd[i] = (f32x4){0.f, 0.f, 0.f, 0.f}; yo[i] = (f32x4){0.f, 0.f, 0.f, 0.f}; }
#pragma unroll
            for (int ks = 0; ks < 4; ++ks) { const bf16x8 am = ldsfrag(Bs, 16 * wave + r16, S_LD, 32 * ks + kq), ac = ldsfrag(Cs, 16 * wave + r16, S_LD, 32 * ks + kq);
#pragma unroll
                for (int pt = 0; pt < 4; ++pt) { yd[pt] = MFMA16(am, ldsfrag(XT, 16 * pt + r16, S_LD, 32 * ks + kq), yd[pt]);
                    yo[pt] = MFMA16(ac, ldsfrag(SB, 16 * pt + r16, S_LD, 32 * ks + kq), yo[pt]); } }
#pragma unroll
            for (int j = 0; j < 4; ++j) { const int lidx = 16 * wave + 4 * q4 + j; const float ea = __expf(ACS[lidx]);
                const size_t row = rowbase + t0 + lidx;
#pragma unroll
                for (int pt = 0; pt < 4; ++pt) { const int p = 16 * pt + r16;
                    const float z = bf2f(proj[row * NPROJ + P_Z + 64 * h + p]);
                    const float y = (yd[pt][j] + ea * yo[pt][j]) * (z * sigm(z));
                    Yb[row * 512 + 64 * h + p] = (bf16_t)f2bf(y); } }
        }
        {
            const float dec = __expf(acsL);
#pragma unroll
            for (int pt = 0; pt < 4; ++pt) st[pt] = st[pt] * dec;
#pragma unroll
            for (int ks = 0; ks < 4; ++ks) { const bf16x8 bf = ldsfrag(BT, 16 * wave + r16, S_LD, 32 * ks + kq);
#pragma unroll
                for (int pt = 0; pt < 4; ++pt) st[pt] = MFMA16(ldsfrag(XT, 16 * pt + r16, S_LD, 32 * ks + kq), bf, st[pt]); }
        }
        __syncthreads();
#pragma unroll
        for (int pt = 0; pt < 4; ++pt)
#pragma unroll
            for (int j = 0; j < 4; ++j) SB[(16 * pt + 4 * q4 + j) * S_LD + 16 * wave + r16] = (bf16_t)f2bf(st[pt][j]);
    }
    __syncthreads();
}

constexpr int F_U = 0, F_SP = 67584;
__device__ __forceinline__ float gelu_tanh(float x) { const float u = 0.7978845608028654f * (x + 0.044715f * x * x * x); return 0.5f * x * (1.f + ftanh(u)); }
__device__ __forceinline__ void s5_unit(KArgs ap_, int l, int b, int g, LAS unsigned char* lds, int tid, int lane, int wave) {
    KArgs ap = ap_; asm volatile("" : "+s"(ap)); KArgsRef a = *ap; tid = opq(tid); lane = opq(lane);
    unsigned char* ws = a.ws;
    const bf16_t* proj = (const bf16_t*)(ws + WS_PROJ);
    bf16_t* ZG = (bf16_t*)(ws + WS_ZG);
    const bf16_t* tm = (const bf16_t*)(ws + WS_TM) + (size_t)g * 384 * 256;
    const bf16_t* m3 = (const bf16_t*)(ws + WS_M3) + (size_t)g * 256 * 128;
    const float* A16 = (const float*)(ws + WS_A16) + g * 128;
    LAS bf16_t* U = (LAS bf16_t*)(lds + F_U); LAS float* ST = (LAS float*)(lds + F_U); LAS bf16_t* SP = (LAS bf16_t*)(lds + F_SP);
    LAS unsigned char* ZL = lds + F_U;
    const size_t rowbase = (size_t)b * SEQ;
    const int r16 = lane & 15, q4 = lane >> 4, kq = 8 * q4;
    u32x4 ur[8];
#pragma unroll
    for (int j = 0; j < 8; ++j) { const int i = tid + NTHR * j, t = i >> 1, hf = i & 1; ur[j] = *(const u32x4*)(proj + (rowbase + t) * NPROJ + P_U + 16 * g + 8 * hf); }
    bf16x8 bf[8][3];
#pragma unroll
    for (int ks = 0; ks < 4; ++ks) { const int k = 32 * ks + kq;
        bf[ks][0] = *(const bf16x8*)(tm + (size_t)(32 * wave + r16) * 256 + k); bf[ks][1] = *(const bf16x8*)(tm + (size_t)(32 * wave + 16 + r16) * 256 + k); bf[ks][2] = *(const bf16x8*)(tm + (size_t)(256 + 16 * wave + r16) * 256 + k); }
#pragma unroll
    for (int j = 0; j < 8; ++j) { const int i = tid + NTHR * j, t = i >> 1, hf = i & 1; *(LAS u32x4*)(U + (t >> 4) * 264 + (t & 15) * 16 + 8 * hf) = ur[j]; }
    asm volatile("" ::: "memory");
#pragma unroll
    for (int ks = 4; ks < 8; ++ks) { const int k = 32 * ks + kq;
        bf[ks][0] = *(const bf16x8*)(tm + (size_t)(32 * wave + r16) * 256 + k); bf[ks][1] = *(const bf16x8*)(tm + (size_t)(32 * wave + 16 + r16) * 256 + k); bf[ks][2] = *(const bf16x8*)(tm + (size_t)(256 + 16 * wave + r16) * 256 + k); }
    __syncthreads();
    f32x4 ay[8][2], as_[8];
#pragma unroll
    for (int m = 0; m < 8; ++m) { ay[m][0] = (f32x4){0.f, 0.f, 0.f, 0.f}; ay[m][1] = (f32x4){0.f, 0.f, 0.f, 0.f}; as_[m] = (f32x4){0.f, 0.f, 0.f, 0.f}; }
#pragma unroll
    for (int ks = 0; ks < 8; ++ks) { const int k = 32 * ks + kq;
#pragma unroll
        for (int m = 0; m < 8; ++m) { const bf16x8 af = ldsfrag(U, 16 * m + r16, 264, k);
            ay[m][0] = MFMA16(af, bf[ks][0], ay[m][0]); ay[m][1] = MFMA16(af, bf[ks][1], ay[m][1]); as_[m] = MFMA16(af, bf[ks][2], as_[m]); } }
    bf16x8 mf[4][2];
#pragma unroll
    for (int ks = 0; ks < 4; ++ks) { const int k = 32 * ks + kq;
        mf[ks][0] = *(const bf16x8*)(m3 + (size_t)(32 * wave + r16) * 128 + k); mf[ks][1] = *(const bf16x8*)(m3 + (size_t)(32 * wave + 16 + r16) * 128 + k); }
    __syncthreads();
#pragma unroll
    for (int m = 0; m < 8; ++m)
#pragma unroll
        for (int j = 0; j < 4; ++j) ST[(16 * m + 4 * q4 + j) * 128 + 16 * wave + r16] = as_[m][j];
    __syncthreads();
    if (tid < 64) { const int n = tid; const float ar = A16[2 * n], ai = A16[2 * n + 1]; float sr = 0.f, si = 0.f;
#pragma unroll 8
        for (int c = 0; c < 128; ++c) { *(LAS unsigned*)(SP + c * 136 + 2 * n) = pk2(sr, si);
            const f32x2 t = *(LAS f32x2*)(ST + c * 128 + 2 * n);
            const float nr = ar * sr - ai * si + t.x, ni = ar * si + ai * sr + t.y; sr = nr; si = ni; } }
    __syncthreads();
#pragma unroll
    for (int ks = 0; ks < 4; ++ks) { const int k = 32 * ks + kq;
#pragma unroll
        for (int m = 0; m < 8; ++m) { const bf16x8 af = ldsfrag(SP, 16 * m + r16, 136, k);
            ay[m][0] = MFMA16(af, mf[ks][0], ay[m][0]); ay[m][1] = MFMA16(af, mf[ks][1], ay[m][1]); } }
    __syncthreads();
#pragma unroll
    for (int m = 0; m < 8; ++m)
#pragma unroll
        for (int e = 0; e < 2; ++e)
#pragma unroll
            for (int j = 0; j < 4; ++j) { const int c = 16 * m + 4 * q4 + j, tok = 16 * c + 2 * wave + e;
                *(LAS bf16_t*)(ZL + tok * 32 + c * 32 + 2 * r16) = (bf16_t)f2bf(gelu_tanh(ay[m][e][j])); }
    __syncthreads();
#pragma unroll
    for (int j = 0; j < 8; ++j) { const int i = tid + NTHR * j, t = i >> 1, hf = i & 1;
        *(u32x4*)(ZG + (rowbase + t) * 512 + 16 * g + 8 * hf) = *(const LAS u32x4*)(ZL + t * 32 + (t >> 4) * 32 + 16 * hf); }
    __syncthreads();
}

__device__ __forceinline__ void ssd_norm_rows(KArgs ap_, int l, int gw, int NGW, int lane) {
    KArgs ap = ap_; asm volatile("" : "+s"(ap)); KArgsRef a = *ap; lane = opq(lane);
    bf16_t* Yb = (bf16_t*)(a.ws + WS_YB);
    const float* ng = a.in[20] + l * 512 + 8 * lane;
    const f32x4 g0 = *(const f32x4*)ng, g1 = *(const f32x4*)(ng + 4);
    for (int m = gw; m < MTOK; m += 4 * NGW) {
        u32x4 raw[4];
#pragma unroll
        for (int r = 0; r < 4; ++r) raw[r] = *(const u32x4*)(Yb + (size_t)(m + r * NGW) * 512 + 8 * lane);
#pragma unroll
        for (int r = 0; r < 4; ++r) {
            float v[8]; unpack8(raw[r], v);
            float s = 0.f;
#pragma unroll
            for (int e = 0; e < 8; ++e) s += v[e] * v[e];
            s = red32(s);
            const float rinv = __builtin_amdgcn_rsqf(s * (1.f / 256.f) + 1e-5f);
            v[0] *= rinv * g0.x; v[1] *= rinv * g0.y; v[2] *= rinv * g0.z; v[3] *= rinv * g0.w; v[4] *= rinv * g1.x; v[5] *= rinv * g1.y; v[6] *= rinv * g1.z; v[7] *= rinv * g1.w;
            *(u32x4*)(Yb + (size_t)(m + r * NGW) * 512 + 8 * lane) = pack8(v);
        }
    }
}

__device__ __forceinline__ void final_norm_rows(const bf16_t* X, float* O, const float* gamma, int gw, int NGW, int lane) {
    lane = opq(lane);
    f32x4 g[4];
#pragma unroll
    for (int j = 0; j < 4; ++j) g[j] = *(const f32x4*)(gamma + 4 * lane + 256 * j);
    for (int m = gw; m < MTOK; m += 4 * NGW) {
        f32x4 v[4][4]; float s[4];
#pragma unroll
        for (int r = 0; r < 4; ++r) { const bf16_t* xr = X + (size_t)(m + r * NGW) * DM + 4 * lane; s[r] = 0.f;
#pragma unroll
            for (int j = 0; j < 4; ++j) { const u32x2 w = *(const u32x2*)(xr + 256 * j); v[r][j] = (f32x4){bf_lo(w.x), bf_hi(w.x), bf_lo(w.y), bf_hi(w.y)};
                s[r] += (v[r][j].x * v[r][j].x + v[r][j].y * v[r][j].y) + (v[r][j].z * v[r][j].z + v[r][j].w * v[r][j].w); } }
#pragma unroll
        for (int r = 0; r < 4; ++r) { float* xr = O + (size_t)(m + r * NGW) * DM + 4 * lane;
            const float rinv = 1.f / sqrtf(wave_sum(s[r]) * (1.f / DM) + 1e-6f);
#pragma unroll
            for (int j = 0; j < 4; ++j) *(f32x4*)(xr + 256 * j) = v[r][j] * rinv * g[j]; }
    }
}

#define XB_TMO      128
#define XB_XCNT(j)  (256  + 64 * (j))
#define XB_XSUB(j)  (1280 + 64 * (j))
#define XB_XGEN(j)  (2304 + 64 * (j))
#define XB_TOP      3328
#define XB_TOPGEN   3392
#define XCD_BAR_WORDS 3456
#define XB_SPIN_CAP (1u << 18)

__device__ __forceinline__ unsigned xb_ld(unsigned* p)              { return __hip_atomic_load(p, __ATOMIC_RELAXED, __HIP_MEMORY_SCOPE_AGENT); }
__device__ __forceinline__ unsigned xb_add(unsigned* p, unsigned v) { return __hip_atomic_fetch_add(p, v, __ATOMIC_RELAXED, __HIP_MEMORY_SCOPE_AGENT); }
__device__ __forceinline__ unsigned xb_xcc_id() { return (unsigned)__builtin_amdgcn_s_getreg((3 << 11) | 20) & 0xFu; }
#define XB_SPIN(cond, bar) do { unsigned _sp = 0; while (cond) { __builtin_amdgcn_s_sleep(1); \
    if ((++_sp & 255u) == 0u) { if (xb_ld(&(bar)[XB_TMO])) break; if (_sp > XB_SPIN_CAP) { atomicAdd(&(bar)[XB_TMO], 1u); break; } } } } while (0)

struct XcdBarrier {
    unsigned* bar; unsigned x; unsigned G;
    volatile LAS unsigned* st;
};

__device__ __forceinline__ XcdBarrier xcd_barrier_post(unsigned* bar, volatile LAS unsigned* st) {
    XcdBarrier b; b.bar = bar; b.x = xb_xcc_id(); b.st = st; b.G = gridDim.x;
    if (threadIdx.x == 0) (void)xb_add(&bar[XB_XCNT(b.x)], 1u);
    return b;
}
__device__ __forceinline__ void xcd_barrier_complete(unsigned* bar, unsigned x, unsigned G, unsigned& nloc, unsigned& nx) {
    unsigned sum, cnt, mine, sp = 0u;
    for (;;) {
        sum = 0u; cnt = 0u; mine = 0u;
#pragma unroll
        for (unsigned j = 0; j < 16; ++j) { const unsigned c = xb_ld(&bar[XB_XCNT(j)]); sum += c; cnt += (c > 0u) ? 1u : 0u; mine = (j == x) ? c : mine; }
        if (sum == G) break;
        __builtin_amdgcn_s_sleep(1);
        if ((++sp & 255u) == 0u) { if (xb_ld(&bar[XB_TMO])) break; if (sp > XB_SPIN_CAP) { atomicAdd(&bar[XB_TMO], 1u); break; } }
    }
    nloc = mine > 0u ? mine : 1u; nx = cnt > 0u ? cnt : 1u;
}

__device__ __forceinline__ void xcd_barrier(const XcdBarrier& b) {
    asm volatile("s_waitcnt vmcnt(0)" ::: "memory");
    __syncthreads();
    if (threadIdx.x == 0) {
        unsigned* bar = b.bar;
        __builtin_amdgcn_s_waitcnt(0);
        unsigned nloc = b.st[0], nx = b.st[1];
        if (nloc == 0u) { xcd_barrier_complete(bar, b.x, b.G, nloc, nx); b.st[0] = nloc; b.st[1] = nx; }
        const unsigned old = xb_add(&bar[XB_XSUB(b.x)], 1u);
        const unsigned gen = old / nloc;
        if (old + 1u == (gen + 1u) * nloc) {
            __builtin_amdgcn_fence(__ATOMIC_RELEASE, "agent");
            asm volatile("s_waitcnt vmcnt(0)" ::: "memory");
            const unsigned og = xb_add(&bar[XB_TOP], 1u);
            const unsigned tg = og / nx;
            if (og + 1u == (tg + 1u) * nx) xb_add(&bar[XB_TOPGEN], 1u);
            else XB_SPIN(xb_ld(&bar[XB_TOPGEN]) == tg, bar);
            __builtin_amdgcn_fence(__ATOMIC_ACQUIRE, "agent");
            xb_add(&bar[XB_XGEN(b.x)], 1u);
            asm volatile("s_waitcnt vmcnt(0)" ::: "memory");
        } else {
            XB_SPIN(xb_ld(&bar[XB_XGEN(b.x)]) == gen, bar);
            __builtin_amdgcn_fence(__ATOMIC_ACQUIRE, "agent");
            asm volatile("s_waitcnt vmcnt(0)" ::: "memory");
        }
    }
    __syncthreads();
}


#ifndef PHM
#define PHM 63
#endif
#define GEMM_PHASE(EPI, AOFF, BOFF, N_, K_, E_) do { pg8::Gemm g_{(const pg8::bf16_t*)(ws + (AOFF)), (const pg8::bf16_t*)(ws + (BOFF)), MTOK, (N_), (K_)}; pg8::StaticOrder S_; S_.init(MTOK, (N_), (int)gridDim.x, (int)blockIdx.x); \
    pg8::gemm_phase<EPI, pg8::StaticOrder, true, true>(lds, g_, S_, (E_)); } while (0)
#define FRESH() KArgs ap = kargs(); unsigned char* ws = ap->ws; (void)ws

__global__ void __launch_bounds__(NTHR, 2) hybrid_fwd(Args a_unused) {
    extern __shared__ __attribute__((aligned(16))) unsigned char lds_raw[];
    LAS unsigned char* lds = (LAS unsigned char*)lds_raw;
    cg::grid_group grid = cg::this_grid();
    volatile LAS unsigned* bst = (volatile LAS unsigned*)(lds + LDS_BYTES - 64);
    if (threadIdx.x < 4) bst[threadIdx.x] = 0u;
    __syncthreads();
    XcdBarrier xbar = xcd_barrier_post((unsigned*)kargs()->ws, bst);
    XcdBarrier xsub = xbar;
    if ((int)blockIdx.x >= 128) { xsub = xcd_barrier_post((unsigned*)kargs()->ws + 4096, bst + 2); xsub.G = gridDim.x - 128; }
    grid.sync();
    const int tid = threadIdx.x, lane = tid & 63, wave = __builtin_amdgcn_readfirstlane(tid >> 6);
    const int gw = blockIdx.x * NWAVES + wave, NGW = gridDim.x * NWAVES;
#pragma unroll 1
    for (int l = 0; l < DEPTH; ++l) {
        { FRESH();
#ifndef NO_PREP
          phase_prep(ap, l, l == 0 ? (const void*)ap->in[0] : (const void*)ap->out, lds, tid, lane, wave);
#endif
        }
        xcd_barrier(xbar);
        if (PHM & 1) { FRESH(); pg8::EpiStore E{(bf16_t*)(ws + WS_PROJ), NPROJ}; GEMM_PHASE(pg8::EpiStore, WS_H, WS_WIN, NPROJ, 1024, E); }
        xcd_barrier(xbar);
#ifndef REPC
#define REPC 1
#endif
#pragma unroll 1
        for (int rep = 0; rep < REPC; ++rep) { FRESH();
          if ((int)blockIdx.x < 128) {
#ifndef NO_RWKV
            rwkv_unit(ap, l, blockIdx.x >> 3, blockIdx.x & 7, lds, tid, lane, wave);
#endif
          } else { const int u = blockIdx.x - 128;
#ifndef NO_SSD
#ifndef REPS
#define REPS 1
#endif
#pragma unroll 1
            for (int rs = 0; rs < REPS; ++rs) ssd_unit(ap, l, u >> 3, u & 7, lds, tid, lane, wave);
#endif
#ifndef NO_S5
#pragma unroll 1
            for (int s = u; s < 512; s += 128) s5_unit(ap, l, s >> 5, s & 31, lds, tid, lane, wave);
#endif
            xcd_barrier(xsub);
            { KArgs ap3 = kargs(); ssd_norm_rows(ap3, l, u * NWAVES + wave, 128 * NWAVES, lane); }
            { KArgs ap3 = kargs(); unsigned char* ws3 = ap3->ws;
              pg8::Gemm g_{(const pg8::bf16_t*)(ws3 + WS_ZG), (const pg8::bf16_t*)(ws3 + WS_GLU), MTOK, 512, 512}; pg8::StaticOrder S_; S_.init(MTOK, 512, 128, u);
              pg8::EpiGlu EG{(const bf16_t*)(ws3 + WS_ZG), (bf16_t*)(ws3 + WS_YC), ap3->in[31] + l * 512}; pg8::gemm_phase<pg8::EpiGlu, pg8::StaticOrder, true, true>(lds, g_, S_, EG); }
            { KArgs ap2 = kargs(); unsigned char* ws2 = ap2->ws;
              pg8::Gemm g_{(const pg8::bf16_t*)(ws2 + WS_H), (const pg8::bf16_t*)(ws2 + WS_WG + (size_t)2 * 1024 * 1024 * 2), MTOK, 1024, 1024}; pg8::StaticOrder S_; S_.init(MTOK, 1024, 128, u);
              pg8::EpiSigU8 E8{ws2 + WS_GC8}; pg8::gemm_phase<pg8::EpiSigU8, pg8::StaticOrder, true, true>(lds, g_, S_, E8); }
          } }
        xcd_barrier(xbar);
        if (PHM & 4) {
            { FRESH(); pg8::EpiStore ES{(bf16_t*)(ws + WS_TT), 1024}; GEMM_PHASE(pg8::EpiStore, WS_YA, WS_PA, 1024, 512, ES); }
            { FRESH(); pg8::EpiGate<true> EG{(const bf16_t*)(ws + WS_TT), (bf16_t*)(ws + WS_MERGED)}; GEMM_PHASE(pg8::EpiGate<true>, WS_H, WS_WG, 1024, 1024, EG); }
            { FRESH(); pg8::EpiStore ES{(bf16_t*)(ws + WS_TT), 1024}; GEMM_PHASE(pg8::EpiStore, WS_YB, WS_PB, 1024, 512, ES); }
            { FRESH(); pg8::EpiGate<false> EG{(const bf16_t*)(ws + WS_TT), (bf16_t*)(ws + WS_MERGED)}; GEMM_PHASE(pg8::EpiGate<false>, WS_H, WS_WG + (size_t)1024 * 1024 * 2, 1024, 1024, EG); }
            { FRESH(); pg8::EpiMulAccU8 EM{ws + WS_GC8, (bf16_t*)(ws + WS_MERGED)}; GEMM_PHASE(pg8::EpiMulAccU8, WS_YC, WS_PC, 1024, 512, EM); }
        }
        xcd_barrier(xbar);
        if (PHM & 8) { FRESH();
            if (l == 0) { pg8::EpiResid<false> E{(const void*)ap->in[0], (bf16_t*)ap->out}; GEMM_PHASE(pg8::EpiResid<false>, WS_MERGED, WS_WOUT, 1024, 1024, E); }
            else { pg8::EpiResid<true> E{(const void*)ap->out, (bf16_t*)ap->out}; GEMM_PHASE(pg8::EpiResid<true>, WS_MERGED, WS_WOUT, 1024, 1024, E); } }
        xcd_barrier(xbar);
        { FRESH(); rmsnorm_rows<false, true>((const void*)ap->out, ap->in[34] + l * DM, (bf16_t*)(ws + WS_H), nullptr, nullptr, gw, NGW, lane); }
        xcd_barrier(xbar);
        if (PHM & 16) { FRESH(); pg8::EpiSwiglu E{(bf16_t*)(ws + WS_ACT)}; GEMM_PHASE(pg8::EpiSwiglu, WS_H, WS_FIN, 2 * FFH, 1024, E); }
        xcd_barrier(xbar);
        if (PHM & 32) { FRESH(); pg8::EpiResid<true> E{(const void*)ap->out, l == DEPTH - 1 ? (bf16_t*)(ws + WS_XF) : (bf16_t*)ap->out}; GEMM_PHASE(pg8::EpiResid<true>, WS_ACT, WS_FOUT, 1024, FFH, E); }
        xcd_barrier(xbar);
    }
    { KArgs ap = kargs(); final_norm_rows((const bf16_t*)(ap->ws + WS_XF), ap->out, ap->in[37], gw, NGW, lane); }
}

extern "C" void kernel_launch(void* const* d_in, const int* in_sizes, int n_in, void* d_out, int out_size, void* d_ws, size_t ws_size, hipStream_t stream) {
    static int grid = 0;
    if (grid == 0) {
        if (n_in != 38 || out_size != MTOK * DM || ws_size < WS_END) { fprintf(stderr, "kernel_launch: unexpected problem (n_in %d out %d ws %zu, need %zu)\n", n_in, out_size, ws_size, (size_t)WS_END); grid = -1; return; }
        int dev = 0, cus = 0, per_cu = 0;
        (void)hipGetDevice(&dev); (void)hipDeviceGetAttribute(&cus, hipDeviceAttributeMultiprocessorCount, dev);
        if (hipFuncSetAttribute((const void*)hybrid_fwd, hipFuncAttributeMaxDynamicSharedMemorySize, LDS_BYTES) != hipSuccess) { fprintf(stderr, "kernel_launch: hipFuncSetAttribute failed\n"); grid = -1; return; }
        if (hipOccupancyMaxActiveBlocksPerMultiprocessor(&per_cu, (const void*)hybrid_fwd, NTHR, LDS_BYTES) != hipSuccess || per_cu < 1) { fprintf(stderr, "kernel_launch: occupancy query says %d\n", per_cu); per_cu = 1; }
        (void)hipGetLastError();
        grid = cus;
        if (grid != 256) { fprintf(stderr, "kernel_launch: expected 256 CUs, got %d\n", grid); grid = -1; return; }
    }
    if (grid < 0) return;
    Args a{};
    for (int i = 0; i < 38; ++i) a.in[i] = (const float*)d_in[i];
    a.out = (float*)d_out; a.ws = (unsigned char*)d_ws;
    (void)hipMemsetAsync(d_ws, 0, 32768, stream);
    void* args[] = {&a};
    hipError_t e = hipLaunchCooperativeKernel((const void*)hybrid_fwd, dim3(grid), dim3(NTHR), args, LDS_BYTES, stream);
    if (e != hipSuccess) fprintf(stderr, "cooperative launch failed: %s (grid %d)\n", hipGetErrorString(e), grid);
}
```

```cpp
#include <hip/hip_runtime.h>
#include <hip/hip_cooperative_groups.h>
#include <cstdio>
#include <cstdint>
namespace cg = cooperative_groups;

namespace pg8 {
#define PG8_LAS __attribute__((address_space(3)))
typedef unsigned short bf16_t;
typedef short bf16x8 __attribute__((ext_vector_type(8)));
typedef float f32x4 __attribute__((ext_vector_type(4)));
typedef unsigned u32x4 __attribute__((ext_vector_type(4)));
constexpr int BM = 256, BK = 64, HALF = 128, HTB = HALF * BK * 2  , STAGE_BYTES = 8 * HTB, NXCD = 8, WGM = 4;

__host__ __device__ __forceinline__ int lds_byte(int r, int c) { const int st = (r >> 4) * 2 + (c >> 5), rr = r & 15, cc = c & 31, ob = rr * 64 + cc * 2; return st * 1024 + (ob ^ (((ob >> 9) & 1) << 5)); }
__host__ __device__ __forceinline__ void stage_rc(int b, int& R, int& C) { const int st = b / 1024, sb = b % 1024, swz = sb ^ (((sb >> 9) & 1) << 5); R = (st >> 1) * 16 + swz / 64; C = (st & 1) * 32 + (swz % 64) / 2; }
__host__ __device__ __forceinline__ int perm32(int rho) { const int n = rho >> 4, i = rho & 15; return 8 * (i >> 2) + 4 * n + (i & 3); }

struct Unit { int pm, pn; };
struct Gemm { const bf16_t* A; const bf16_t* Bt; int M, N, K; };

struct StaticOrder {
    int nM, nN, nwg, G, c;
    __host__ __device__ void init(int M, int N, int G_, int c_) { nM = M / BM; nN = N / BM; nwg = nM * nN; G = G_; c = c_; }
    __host__ __device__ bool next(int i, Unit& u) const {
        const long L = (long)i * G + c; if (L >= nwg) return false;
        int wgid = (int)L; { const int q = nwg / NXCD, r = nwg % NXCD, xcd = wgid % NXCD, off = wgid / NXCD; wgid = (xcd < r ? xcd * (q + 1) : r * (q + 1) + (xcd - r) * q) + off; }
        const int nig = WGM * nN, gid = wgid / nig, fm = gid * WGM, gsz = (nM - fm) < WGM ? (nM - fm) : WGM;
        u.pm = fm + ((wgid % nig) % gsz); u.pn = (wgid % nig) / gsz; return true;
    }
    __device__ __forceinline__ void a_ready(const Unit&) const {}
    __device__ __forceinline__ void done(const Unit&) const {}
};

template <class Epi, class Sched, bool ALIGN_EPI = false, bool SP2 = false>
__device__ __forceinline__ void gemm_phase(PG8_LAS unsigned char* lds, const Gemm g, const Sched& S, const Epi& E) {
    int tid_ = threadIdx.x; asm volatile("" : "+v"(tid_));
    const int tid = tid_, wid = __builtin_amdgcn_readfirstlane(tid >> 6), lane = tid & 63, wr = wid >> 2, wc = wid & 3, fr = lane & 15, fq = lane >> 4;
    const int K = g.K, nt = K / BK;
    unsigned voffA[2], voffB[2];
#pragma unroll
    for (int i = 0; i < 2; ++i) { int R, C; stage_rc(tid * 16 + i * 8192, R, C); const int Rb = Epi::PERM ? ((R & ~31) + perm32(R & 31)) : R;
        voffA[i] = (unsigned)(R * K + C) * 2u; voffB[i] = (unsigned)(Rb * K + C) * 2u; }
    const size_t kstep = (size_t)(BK * 2);
    const size_t hstep = (size_t)HALF * K * 2;
    const size_t tstep = 2 * hstep;
    const unsigned ldsw = (unsigned)wid * 1024u;
    const int aoff = lds_byte(wr * 64 + fr, fq * 8), boff = lds_byte(wc * 32 + fr, fq * 8);
#define PG8_SA(b, h) (((b) * 2 + (h)) * HTB)
#define PG8_SB(b, h) ((4 + (b) * 2 + (h)) * HTB)
#define PG8_STAGE(bufoff, gbase, voff) do { _Pragma("unroll") for (int _i = 0; _i < 2; ++_i) \
        __builtin_amdgcn_global_load_lds((const unsigned*)((const char*)(gbase) + (voff)[_i]), (PG8_LAS unsigned*)(lds + (bufoff) + ldsw + _i * 8192), 16, 0, 0); } while (0)
#define PG8_LDA(dst, b, h) do { _Pragma("unroll") for (int m = 0; m < 4; ++m) _Pragma("unroll") for (int k = 0; k < 2; ++k) dst[m][k] = *(const PG8_LAS bf16x8*)(lds + PG8_SA(b, h) + aoff + m * 2048 + k * 1024); } while (0)
#define PG8_LDB(dst, b, h) do { _Pragma("unroll") for (int n = 0; n < 2; ++n) _Pragma("unroll") for (int k = 0; k < 2; ++k) dst[n][k] = *(const PG8_LAS bf16x8*)(lds + PG8_SB(b, h) + boff + n * 2048 + k * 1024); } while (0)
#define PG8_MMA(ai, bj, At, Bt) do { __builtin_amdgcn_s_setprio(1); _Pragma("unroll") for (int m = 0; m < 4; ++m) _Pragma("unroll") for (int n = 0; n < 2; ++n) _Pragma("unroll") for (int k = 0; k < 2; ++k) \
        acc[ai][bj][m][n] = __builtin_amdgcn_mfma_f32_16x16x32_bf16(Bt[n][k], At[m][k], acc[ai][bj][m][n], 0, 0, 0); __builtin_amdgcn_s_setprio(0); } while (0)
#define PG8_WAIT_V(n) asm volatile("s_waitcnt vmcnt(" #n ")" ::: "memory")
#define PG8_WAIT_L(n) asm volatile("s_waitcnt lgkmcnt(" #n ")" ::: "memory")
#define PG8_BAR __builtin_amdgcn_s_barrier()
#define PG8_SCHED __builtin_amdgcn_sched_barrier(0)
    Unit cur, nxt; int ui = 0;
    if (!S.next(0, cur)) return;
    f32x4 acc[2][2][4][2];
#pragma unroll
    for (int a = 0; a < 2; ++a)
#pragma unroll
        for (int b = 0; b < 2; ++b)
#pragma unroll
            for (int m = 0; m < 4; ++m)
#pragma unroll
                for (int n = 0; n < 2; ++n) acc[a][b][m][n] = (f32x4){0.f, 0.f, 0.f, 0.f};
    bf16x8 At[4][2], B0[2][2], B1[2][2];
    const char* cA = (const char*)g.A + (size_t)cur.pm * tstep; const char* cB = (const char*)g.Bt + (size_t)cur.pn * tstep;
    S.a_ready(cur);
    if constexpr (SP2) {
        PG8_STAGE(PG8_SB(0, 0), cB, voffB); PG8_STAGE(PG8_SB(0, 1), cB + hstep, voffB); PG8_STAGE(PG8_SA(0, 0), cA, voffA); PG8_STAGE(PG8_SA(0, 1), cA + hstep, voffA);
        if (wr == 1) PG8_BAR;
        PG8_WAIT_V(2); PG8_BAR;
        PG8_STAGE(PG8_SB(1, 0), cB + kstep, voffB); PG8_STAGE(PG8_SA(1, 0), cA + kstep, voffA); PG8_STAGE(PG8_SB(1, 1), cB + hstep + kstep, voffB);
        PG8_WAIT_V(6); PG8_BAR;
    } else {
        PG8_STAGE(PG8_SB(0, 0), cB, voffB); PG8_STAGE(PG8_SA(0, 0), cA, voffA); PG8_STAGE(PG8_SB(0, 1), cB + hstep, voffB); PG8_STAGE(PG8_SA(0, 1), cA + hstep, voffA);
        if (wr == 1) PG8_BAR;
        PG8_WAIT_V(4); PG8_BAR;
        PG8_STAGE(PG8_SB(1, 0), cB + kstep, voffB); PG8_STAGE(PG8_SA(1, 0), cA + kstep, voffA); PG8_STAGE(PG8_SB(1, 1), cB + hstep + kstep, voffB);
        PG8_WAIT_V(6); PG8_BAR;
    }
    for (;;) {
        const bool has_next = S.next(ui + 1, nxt);
        const char* nA = has_next ? (const char*)g.A + (size_t)nxt.pm * tstep : cA; const char* nB = has_next ? (const char*)g.Bt + (size_t)nxt.pn * tstep : cB;
        for (int t = 0; t < nt; t += 2) {
            const bool last = (t == nt - 2);
            const char* a1 = cA + (size_t)(t + 1) * kstep;
            const char* a2 = last ? nA : cA + (size_t)(t + 2) * kstep; const char* b2 = last ? nB : cB + (size_t)(t + 2) * kstep;
            const char* a3 = a2 + kstep; const char* b3 = b2 + kstep;
            if (last && has_next) S.a_ready(nxt);
            if constexpr (SP2) {
            PG8_LDB(B0, 0, 0); PG8_LDB(B1, 0, 1); PG8_SCHED; PG8_LDA(At, 0, 0); PG8_STAGE(PG8_SA(1, 1), a1 + hstep, voffA);
            PG8_WAIT_V(8); PG8_WAIT_L(0); PG8_BAR; PG8_MMA(0, 0, At, B0); PG8_MMA(0, 1, At, B1); PG8_BAR; PG8_SCHED;
            PG8_LDA(At, 0, 1); PG8_STAGE(PG8_SB(0, 0), b2, voffB); PG8_STAGE(PG8_SB(0, 1), b2 + hstep, voffB); PG8_STAGE(PG8_SA(0, 0), a2, voffA);
            PG8_WAIT_V(8); PG8_WAIT_L(0); PG8_BAR; PG8_MMA(1, 0, At, B0); PG8_MMA(1, 1, At, B1); PG8_BAR; PG8_SCHED;
            PG8_LDB(B0, 1, 0); PG8_LDB(B1, 1, 1); PG8_SCHED; PG8_LDA(At, 1, 0); PG8_STAGE(PG8_SA(0, 1), a2 + hstep, voffA);
            PG8_WAIT_V(8); PG8_WAIT_L(0); PG8_BAR; PG8_MMA(0, 0, At, B0); PG8_MMA(0, 1, At, B1); PG8_BAR; PG8_SCHED;
            PG8_LDA(At, 1, 1); PG8_STAGE(PG8_SB(1, 0), b3, voffB); PG8_STAGE(PG8_SB(1, 1), b3 + hstep, voffB); PG8_STAGE(PG8_SA(1, 0), a3, voffA);
            PG8_WAIT_V(8); PG8_WAIT_L(0); PG8_BAR; PG8_MMA(1, 0, At, B0); PG8_MMA(1, 1, At, B1); PG8_BAR; PG8_SCHED;
            } else {
            PG8_LDB(B0, 0, 0); PG8_SCHED; PG8_LDA(At, 0, 0); PG8_STAGE(PG8_SA(1, 1), a1 + hstep, voffA);
            PG8_WAIT_L(8); PG8_BAR; PG8_WAIT_L(0); PG8_MMA(0, 0, At, B0); PG8_BAR; PG8_SCHED;
            PG8_LDB(B1, 0, 1); PG8_STAGE(PG8_SB(0, 0), b2, voffB);
            PG8_BAR; PG8_WAIT_L(0); PG8_MMA(0, 1, At, B1); PG8_BAR;
            PG8_LDA(At, 0, 1); PG8_STAGE(PG8_SA(0, 0), a2, voffA);
            PG8_BAR; PG8_WAIT_L(0); PG8_MMA(1, 0, At, B0); PG8_BAR; PG8_SCHED;
            PG8_STAGE(PG8_SB(0, 1), b2 + hstep, voffB);
            PG8_WAIT_V(6); PG8_BAR; PG8_MMA(1, 1, At, B1); PG8_BAR;
            PG8_LDB(B0, 1, 0); PG8_SCHED; PG8_LDA(At, 1, 0); PG8_STAGE(PG8_SA(0, 1), a2 + hstep, voffA);
            PG8_WAIT_L(8); PG8_BAR; PG8_WAIT_L(0); PG8_MMA(0, 0, At, B0); PG8_BAR; PG8_SCHED;
            PG8_LDB(B1, 1, 1); PG8_STAGE(PG8_SB(1, 0), b3, voffB);
            PG8_BAR; PG8_WAIT_L(0); PG8_MMA(0, 1, At, B1); PG8_BAR;
            PG8_LDA(At, 1, 1); PG8_STAGE(PG8_SA(1, 0), a3, voffA);
            PG8_BAR; PG8_WAIT_L(0); PG8_MMA(1, 0, At, B0); PG8_BAR; PG8_SCHED;
            PG8_STAGE(PG8_SB(1, 1), b3 + hstep, voffB);
            PG8_WAIT_V(6); PG8_BAR; PG8_MMA(1, 1, At, B1); PG8_BAR;
            }
        }
        if constexpr (ALIGN_EPI) { if (wr == 0) PG8_BAR; }
        if constexpr (!Epi::AFTER_DRAIN) { E(acc, cur, wr, wc, fr, fq); S.done(cur); }
        if (!has_next) break;
#pragma unroll
        for (int a = 0; a < 2; ++a)
#pragma unroll
            for (int b = 0; b < 2; ++b)
#pragma unroll
                for (int m = 0; m < 4; ++m)
#pragma unroll
                    for (int n = 0; n < 2; ++n) acc[a][b][m][n] = (f32x4){0.f, 0.f, 0.f, 0.f};
        cur = nxt; cA = nA; cB = nB; ++ui;
        if constexpr (ALIGN_EPI) { if (wr == 1) PG8_BAR; }
    }
    PG8_WAIT_V(0);
    if constexpr (!ALIGN_EPI) { if (wr == 0) PG8_BAR; }
    PG8_BAR;
    if constexpr (Epi::AFTER_DRAIN) { E.fused(acc, cur, wr, wc, fr, fq, lds, wid, lane); S.done(cur); }
#undef PG8_SA
#undef PG8_SB
#undef PG8_STAGE
#undef PG8_LDA
#undef PG8_LDB
#undef PG8_MMA
#undef PG8_WAIT_V
#undef PG8_WAIT_L
#undef PG8_BAR
#undef PG8_SCHED
}
}

#ifndef PG8_SP2
#define PG8_SP2 true
#endif
#ifndef PG8_ALIGN
#define PG8_ALIGN true
#endif

#define LAS __attribute__((address_space(3)))
typedef unsigned short bf16_t;
typedef short bf16x8 __attribute__((ext_vector_type(8)));
typedef float f32x4 __attribute__((ext_vector_type(4)));
typedef float f32x2 __attribute__((ext_vector_type(2)));
typedef unsigned u32x4 __attribute__((ext_vector_type(4)));
typedef unsigned u32x2 __attribute__((ext_vector_type(2)));

__device__ __forceinline__ unsigned f2bf(float f) { unsigned u = __builtin_bit_cast(unsigned, f); return (u + 0x7fffu + ((u >> 16) & 1u)) >> 16; }
__device__ __forceinline__ unsigned pk2(float lo, float hi) { unsigned r; asm volatile("v_cvt_pk_bf16_f32 %0, %1, %2" : "=v"(r) : "v"(lo), "v"(hi)); return r; }
__device__ __forceinline__ float bf_lo(unsigned w) { return __builtin_bit_cast(float, w << 16); }
__device__ __forceinline__ float bf_hi(unsigned w) { return __builtin_bit_cast(float, w & 0xffff0000u); }
__device__ __forceinline__ float bf2f(bf16_t b) { return __builtin_bit_cast(float, (unsigned)b << 16); }
__device__ __forceinline__ void unpack8(u32x4 v, float* o) { o[0] = bf_lo(v.x); o[1] = bf_hi(v.x); o[2] = bf_lo(v.y); o[3] = bf_hi(v.y); o[4] = bf_lo(v.z); o[5] = bf_hi(v.z); o[6] = bf_lo(v.w); o[7] = bf_hi(v.w); }
__device__ __forceinline__ u32x4 pack8(const float* o) { u32x4 v; v.x = pk2(o[0], o[1]); v.y = pk2(o[2], o[3]); v.z = pk2(o[4], o[5]); v.w = pk2(o[6], o[7]); return v; }
__device__ __forceinline__ float sigm(float x) { return __builtin_amdgcn_rcpf(1.f + __expf(-x)); }
__device__ __forceinline__ float ftanh(float x) { return 1.f - 2.f * __builtin_amdgcn_rcpf(1.f + __expf(2.f * x)); }
__device__ __forceinline__ float softplusf(float z) { return z > 20.f ? z : log1pf(expf(z)); }
template <int CTRL> __device__ __forceinline__ float dppf(float x) { return __builtin_bit_cast(float, __builtin_amdgcn_update_dpp(0, __builtin_bit_cast(int, x), CTRL, 0xf, 0xf, true)); }
__device__ __forceinline__ float red8(float x) { x += dppf<0xB1>(x); x += dppf<0x4E>(x); x += dppf<0x141>(x); return x; }
__device__ __forceinline__ float red16(float x) { x = red8(x); x += dppf<0x140>(x); return x; }
__device__ __forceinline__ float red32(float x) { x = red16(x); x += __shfl_xor(x, 16); return x; }
__device__ __forceinline__ float wave_sum(float x) { x = red32(x); x += __shfl_xor(x, 32); return x; }
__device__ __forceinline__ bf16x8 ldsfrag(const LAS bf16_t* base, int row, int stride, int k) { return *(const LAS bf16x8*)(base + row * stride + k); }
#define MFMA16(a, b, c) __builtin_amdgcn_mfma_f32_16x16x32_bf16((a), (b), (c), 0, 0, 0)

namespace pg8 {
struct EpiStore {
    static constexpr bool PERM = true, AFTER_DRAIN = false;
    bf16_t* O; int ldc;
    __device__ __forceinline__ void operator()(const f32x4 (&acc)[2][2][4][2], const Unit& u, int wr, int wc, int fr, int fq) const {
        const int row0 = u.pm * BM + wr * 64 + fr, col0 = u.pn * BM + wc * 32 + 8 * fq;
#pragma unroll
        for (int ai = 0; ai < 2; ++ai)
#pragma unroll
            for (int m = 0; m < 4; ++m) { bf16_t* rowp = O + (size_t)(row0 + ai * HALF + m * 16) * ldc + col0;
#pragma unroll
                for (int bj = 0; bj < 2; ++bj) { const f32x4 v0 = acc[ai][bj][m][0], v1 = acc[ai][bj][m][1];
                    u32x4 w; w.x = pk2(v0[0], v0[1]); w.y = pk2(v0[2], v0[3]); w.z = pk2(v1[0], v1[1]); w.w = pk2(v1[2], v1[3]);
                    *(u32x4*)(rowp + bj * HALF) = w; } }
    }
};
template <bool FIRST> struct EpiGate {
    static constexpr bool PERM = true, AFTER_DRAIN = false;
    const bf16_t* T; bf16_t* Mg;
    __device__ __forceinline__ void operator()(const f32x4 (&acc)[2][2][4][2], const Unit& u, int wr, int wc, int fr, int fq) const {
        const int row0 = u.pm * BM + wr * 64 + fr, col0 = u.pn * BM + wc * 32 + 8 * fq;
#pragma unroll
        for (int ai = 0; ai < 2; ++ai) {
            u32x4 tb[4][2], pb[4][2];
#pragma unroll
            for (int m = 0; m < 4; ++m)
#pragma unroll
                for (int bj = 0; bj < 2; ++bj) { const size_t ro = (size_t)(row0 + ai * HALF + m * 16) * 1024 + col0 + bj * HALF;
                    tb[m][bj] = *(const u32x4*)(T + ro); if (!FIRST) pb[m][bj] = *(const u32x4*)(Mg + ro); }
            asm volatile("" ::: "memory");
#pragma unroll
            for (int m = 0; m < 4; ++m)
#pragma unroll
                for (int bj = 0; bj < 2; ++bj) { const size_t ro = (size_t)(row0 + ai * HALF + m * 16) * 1024 + col0 + bj * HALF;
                    const f32x4 v0 = acc[ai][bj][m][0], v1 = acc[ai][bj][m][1];
                    float t[8], r[8]; unpack8(tb[m][bj], t);
                    r[0] = sigm(v0[0]) * t[0]; r[1] = sigm(v0[1]) * t[1]; r[2] = sigm(v0[2]) * t[2]; r[3] = sigm(v0[3]) * t[3];
                    r[4] = sigm(v1[0]) * t[4]; r[5] = sigm(v1[1]) * t[5]; r[6] = sigm(v1[2]) * t[6]; r[7] = sigm(v1[3]) * t[7];
                    if (!FIRST) { float p[8]; unpack8(pb[m][bj], p);
#pragma unroll
                        for (int e = 0; e < 8; ++e) r[e] += p[e]; }
                    *(u32x4*)(Mg + ro) = pack8(r); }
        }
    }
};
template <bool BASE_BF> struct EpiResid {
    static constexpr bool PERM = true, AFTER_DRAIN = false;
    const void* base; bf16_t* out;
    __device__ __forceinline__ void operator()(const f32x4 (&acc)[2][2][4][2], const Unit& u, int wr, int wc, int fr, int fq) const {
        const int row0 = u.pm * BM + wr * 64 + fr, col0 = u.pn * BM + wc * 32 + 8 * fq;
#pragma unroll
        for (int ai = 0; ai < 2; ++ai) {
            f32x4 bb[4][2][2]; u32x4 bh[4][2];
#pragma unroll
            for (int m = 0; m < 4; ++m)
#pragma unroll
                for (int bj = 0; bj < 2; ++bj) { const size_t ro = (size_t)(row0 + ai * HALF + m * 16) * 1024 + col0 + bj * HALF;
                    if (BASE_BF) bh[m][bj] = *(const u32x4*)((const bf16_t*)base + ro);
                    else { bb[m][bj][0] = *(const f32x4*)((const float*)base + ro); bb[m][bj][1] = *(const f32x4*)((const float*)base + ro + 4); } }
            asm volatile("" ::: "memory");
#pragma unroll
            for (int m = 0; m < 4; ++m)
#pragma unroll
                for (int bj = 0; bj < 2; ++bj) { const size_t ro = (size_t)(row0 + ai * HALF + m * 16) * 1024 + col0 + bj * HALF;
                    float b[8];
                    if (BASE_BF) unpack8(bh[m][bj], b);
                    else { b[0] = bb[m][bj][0].x; b[1] = bb[m][bj][0].y; b[2] = bb[m][bj][0].z; b[3] = bb[m][bj][0].w; b[4] = bb[m][bj][1].x; b[5] = bb[m][bj][1].y; b[6] = bb[m][bj][1].z; b[7] = bb[m][bj][1].w; }
                    const f32x4 v0 = acc[ai][bj][m][0], v1 = acc[ai][bj][m][1];
                    b[0] += v0[0]; b[1] += v0[1]; b[2] += v0[2]; b[3] += v0[3]; b[4] += v1[0]; b[5] += v1[1]; b[6] += v1[2]; b[7] += v1[3];
                    *(u32x4*)(out + ro) = pack8(b); }
        }
    }
};
struct EpiSwiglu {
    static constexpr bool PERM = true, AFTER_DRAIN = false;
    bf16_t* O;
    __device__ __forceinline__ void operator()(const f32x4 (&acc)[2][2][4][2], const Unit& u, int wr, int wc, int fr, int fq) const {
        const int row0 = u.pm * BM + wr * 64 + fr, col0 = u.pn * HALF + wc * 32 + 8 * fq;
#pragma unroll
        for (int ai = 0; ai < 2; ++ai)
#pragma unroll
            for (int m = 0; m < 4; ++m) { bf16_t* p = O + (size_t)(row0 + ai * HALF + m * 16) * 2816 + col0;
                float r[8];
#pragma unroll
                for (int n = 0; n < 2; ++n)
#pragma unroll
                    for (int e = 0; e < 4; ++e) { const float g = acc[ai][0][m][n][e], up = acc[ai][1][m][n][e]; r[4 * n + e] = g * sigm(g) * up; }
                *(u32x4*)p = pack8(r); }
    }
};
struct EpiSigU8 {
    static constexpr bool PERM = true, AFTER_DRAIN = false;
    unsigned char* O;
    __device__ __forceinline__ void operator()(const f32x4 (&acc)[2][2][4][2], const Unit& u, int wr, int wc, int fr, int fq) const {
        const int row0 = u.pm * BM + wr * 64 + fr, col0 = u.pn * BM + wc * 32 + 8 * fq;
#pragma unroll
        for (int ai = 0; ai < 2; ++ai)
#pragma unroll
            for (int m = 0; m < 4; ++m)
#pragma unroll
                for (int bj = 0; bj < 2; ++bj) { const f32x4 v0 = acc[ai][bj][m][0], v1 = acc[ai][bj][m][1];
                    unsigned q[8];
#pragma unroll
                    for (int e = 0; e < 4; ++e) { q[e] = (unsigned)(sigm(v0[e]) * 255.f + 0.5f); q[4 + e] = (unsigned)(sigm(v1[e]) * 255.f + 0.5f); }
                    u32x2 w; w.x = q[0] | (q[1] << 8) | (q[2] << 16) | (q[3] << 24); w.y = q[4] | (q[5] << 8) | (q[6] << 16) | (q[7] << 24);
                    *(u32x2*)(O + (size_t)(row0 + ai * HALF + m * 16) * 1024 + col0 + bj * HALF) = w; }
    }
};
struct EpiMulAccU8 {
    static constexpr bool PERM = true, AFTER_DRAIN = false;
    const unsigned char* G; bf16_t* Mg;
    __device__ __forceinline__ void operator()(const f32x4 (&acc)[2][2][4][2], const Unit& u, int wr, int wc, int fr, int fq) const {
        const int row0 = u.pm * BM + wr * 64 + fr, col0 = u.pn * BM + wc * 32 + 8 * fq;
#pragma unroll
        for (int ai = 0; ai < 2; ++ai) {
            u32x2 gb[4][2]; u32x4 pb[4][2];
#pragma unroll
            for (int m = 0; m < 4; ++m)
#pragma unroll
                for (int bj = 0; bj < 2; ++bj) { const size_t ro = (size_t)(row0 + ai * HALF + m * 16) * 1024 + col0 + bj * HALF;
                    gb[m][bj] = *(const u32x2*)(G + ro); pb[m][bj] = *(const u32x4*)(Mg + ro); }
            asm volatile("" ::: "memory");
#pragma unroll
            for (int m = 0; m < 4; ++m)
#pragma unroll
                for (int bj = 0; bj < 2; ++bj) { const size_t ro = (size_t)(row0 + ai * HALF + m * 16) * 1024 + col0 + bj * HALF;
                    const f32x4 v0 = acc[ai][bj][m][0], v1 = acc[ai][bj][m][1];
                    float p[8], r[8]; unpack8(pb[m][bj], p);
                    const unsigned ga = gb[m][bj].x, gc = gb[m][bj].y; const float k = 1.f / 255.f;
                    r[0] = p[0] + (float)(ga & 255u) * k * v0[0]; r[1] = p[1] + (float)((ga >> 8) & 255u) * k * v0[1]; r[2] = p[2] + (float)((ga >> 16) & 255u) * k * v0[2]; r[3] = p[3] + (float)(ga >> 24) * k * v0[3];
                    r[4] = p[4] + (float)(gc & 255u) * k * v1[0]; r[5] = p[5] + (float)((gc >> 8) & 255u) * k * v1[1]; r[6] = p[6] + (float)((gc >> 16) & 255u) * k * v1[2]; r[7] = p[7] + (float)(gc >> 24) * k * v1[3];
                    *(u32x4*)(Mg + ro) = pack8(r); }
        }
    }
};
struct EpiGlu {
    static constexpr bool PERM = true, AFTER_DRAIN = false;
    const bf16_t* Z; bf16_t* O; const float* bias;
    __device__ __forceinline__ void operator()(const f32x4 (&acc)[2][2][4][2], const Unit& u, int wr, int wc, int fr, int fq) const {
        const int row0 = u.pm * BM + wr * 64 + fr, col0 = u.pn * BM + wc * 32 + 8 * fq;
        f32x4 bv[2][2];
#pragma unroll
        for (int bj = 0; bj < 2; ++bj) { bv[bj][0] = *(const f32x4*)(bias + col0 + bj * HALF); bv[bj][1] = *(const f32x4*)(bias + col0 + bj * HALF + 4); }
#pragma unroll
        for (int ai = 0; ai < 2; ++ai) {
            u32x4 zb[4][2];
#pragma unroll
            for (int m = 0; m < 4; ++m)
#pragma unroll
                for (int bj = 0; bj < 2; ++bj) zb[m][bj] = *(const u32x4*)(Z + (size_t)(row0 + ai * HALF + m * 16) * 512 + col0 + bj * HALF);
            asm volatile("" ::: "memory");
#pragma unroll
            for (int m = 0; m < 4; ++m)
#pragma unroll
                for (int bj = 0; bj < 2; ++bj) { const f32x4 v0 = acc[ai][bj][m][0], v1 = acc[ai][bj][m][1];
                    float z[8], r[8]; unpack8(zb[m][bj], z);
#pragma unroll
                    for (int e = 0; e < 4; ++e) { r[e] = z[e] * sigm(v0[e] + bv[bj][0][e]); r[4 + e] = z[4 + e] * sigm(v1[e] + bv[bj][1][e]); }
                    *(u32x4*)(O + (size_t)(row0 + ai * HALF + m * 16) * 512 + col0 + bj * HALF) = pack8(r); }
        }
    }
};
}

constexpr int DM = 1024, BATCH = 16, SEQ = 2048, MTOK = BATCH * SEQ, DEPTH = 2;
constexpr int IN_COLS = 6920, NPROJ = 3840, FFH = 2816;
constexpr int P_R = 0, P_K = 512, P_V = 1024, P_WD = 1536, P_AD = 1600, P_GD = 1664, P_Z = 1792, P_XS = 2304, P_B = 2816, P_C = 3072, P_U = 3328;
constexpr int NWAVES = 8, NTHR = 512;
constexpr size_t MiB = 1u << 20, KiB = 1u << 10;
constexpr size_t WS_WIN = 1 * MiB, WS_WG = 9 * MiB, WS_PA = 15 * MiB, WS_PB = 16 * MiB, WS_PC = 17 * MiB, WS_GLU = 18 * MiB, WS_WOUT = 19 * MiB,
                 WS_FIN = 21 * MiB, WS_FOUT = 32 * MiB, WS_WUP = 38 * MiB, WS_AUP = 38 * MiB + 64 * KiB, WS_GUP = 38 * MiB + 128 * KiB, WS_A16 = 38 * MiB + 256 * KiB,
                 WS_TM = 39 * MiB, WS_M3 = 45 * MiB, WS_DT = 47 * MiB, WS_H = 48 * MiB, WS_YA = 112 * MiB, WS_YB = 144 * MiB, WS_YC = 176 * MiB, WS_ZG = 208 * MiB,
                 WS_PROJ = 240 * MiB, WS_GC8 = 480 * MiB  , WS_END = 512 * MiB;
constexpr size_t WS_XF = 416 * MiB;
constexpr size_t WS_MERGED = WS_PROJ, WS_TT = WS_PROJ + 64 * MiB, WS_ACT = WS_PROJ;
constexpr int LDS_BYTES = 151552;

struct Args { const float* in[38]; float* out; unsigned char* ws; };
typedef const __attribute__((address_space(4))) Args* KArgs;
typedef const __attribute__((address_space(4))) Args& KArgsRef;
__device__ __forceinline__ KArgs kargs() { KArgs p = (KArgs)__builtin_amdgcn_kernarg_segment_ptr(); asm volatile("" : "+s"(p)); return p; }
__device__ __forceinline__ int opq(int x) { asm volatile("" : "+v"(x)); return x; }

__device__ __forceinline__ void tr_item(const float* __restrict__ W, int ldw, int k0, int c0, bf16_t* __restrict__ WT, int K, int n0, LAS float* scr, int lane) {
    float wv_[32];
#pragma unroll
    for (int i = 0; i < 32; ++i) { const int kk = 2 * i + (lane >> 5); wv_[i] = W[(size_t)(k0 + kk) * ldw + c0 + (lane & 31)]; }
#pragma unroll
    for (int i = 0; i < 32; ++i) { const int kk = 2 * i + (lane >> 5); scr[kk * 33 + (lane & 31)] = wv_[i]; }
    asm volatile("s_waitcnt lgkmcnt(0)" ::: "memory");
    const int c = lane & 7;
#pragma unroll
    for (int j = 0; j < 4; ++j) { const int n = (lane >> 3) + 8 * j; const LAS float* s = scr + (8 * c) * 33 + n;
        u32x4 o; o.x = pk2(s[0 * 33], s[1 * 33]); o.y = pk2(s[2 * 33], s[3 * 33]); o.z = pk2(s[4 * 33], s[5 * 33]); o.w = pk2(s[6 * 33], s[7 * 33]);
        *(u32x4*)(WT + (size_t)(n0 + n) * K + k0 + 8 * c) = o; }
    asm volatile("s_waitcnt lgkmcnt(0)" ::: "memory");
}

__device__ __forceinline__ void s5_prep(KArgs ap_, int l, int g, int q, LAS unsigned char* lds, int tid) {
    KArgs ap = ap_; asm volatile("" : "+s"(ap)); KArgsRef a = *ap; tid = opq(tid);
    LAS float* AR = (LAS float*)lds;
    LAS float* AI = AR + 17 * 64;
    LAS float* BBR = AI + 17 * 64;
    LAS float* BBI = BBR + 1024;
    LAS float* CR = BBI + 1024;
    LAS float* CI = CR + 1024;
    LAS float* KT = CI + 1024;
    unsigned char* ws = a.ws;
    bf16_t* TM = (bf16_t*)(ws + WS_TM) + (size_t)g * 384 * 256;
    bf16_t* M3 = (bf16_t*)(ws + WS_M3) + (size_t)g * 256 * 128;
    float* A16 = (float*)(ws + WS_A16) + g * 128;
    const float* dsk = a.in[29] + l * 512 + 16 * g;
    const float step = expf(a.in[24][l * 32 + g]);
    const float* lre = a.in[22] + (size_t)(l * 32 + g) * 64; const float* lim = a.in[23] + (size_t)(l * 32 + g) * 64;
    for (int e = tid; e < 17 * 64; e += NTHR) { const int t = e >> 6, n = e & 63; const float lr = lre[n], li = lim[n];
        const float mag = expf(lr * step * (float)t), ang = li * step * (float)t; AR[e] = mag * cosf(ang); AI[e] = mag * sinf(ang); }
    for (int e = tid; e < 1024; e += NTHR) { CR[e] = a.in[27][(size_t)(l * 32 + g) * 1024 + e]; CI[e] = a.in[28][(size_t)(l * 32 + g) * 1024 + e]; }
    __syncthreads();
    for (int e = tid; e < 1024; e += NTHR) { const int n = e >> 4, i = e & 15; const float lr = lre[n], li = lim[n];
        const float abr = AR[64 + n], abi = AI[64 + n], den = lr * lr + li * li;
        const float cre = ((abr - 1.f) * lr + abi * li) / den, cim = (abi * lr - (abr - 1.f) * li) / den;
        const float br = a.in[25][((size_t)(l * 32 + g) * 64 + n) * 16 + i], bi = a.in[26][((size_t)(l * 32 + g) * 64 + n) * 16 + i];
        BBR[e] = cre * br - cim * bi; BBI[e] = cre * bi + cim * br; }
    if (q == 0 && tid < 64) { A16[2 * tid] = AR[16 * 64 + tid]; A16[2 * tid + 1] = AI[16 * 64 + tid]; }
    __syncthreads();
    for (int e2 = tid; e2 < 1024; e2 += NTHR) { const int e = 1024 * q + e2; const int t = e >> 8, o = (e >> 4) & 15, i = e & 15; float s = 0.f;
        for (int n = 0; n < 64; ++n) { const float cr = CR[o * 64 + n], ci = CI[o * 64 + n], pr = AR[t * 64 + n], pi = AI[t * 64 + n];
            const float xr = cr * pr - ci * pi, xi = cr * pi + ci * pr; s += xr * BBR[n * 16 + i] - xi * BBI[n * 16 + i]; }
        if (t == 0 && o == i) s += dsk[o];
        KT[e] = s; }
    __syncthreads();
    for (int e = tid; e < 256 * 128; e += NTHR) { const int nn = e >> 7, kk = 2 * (e & 127), t = nn >> 4, o = nn & 15, j = kk >> 4, i = kk & 15, d = t - j;
        if (d >= 0 ? (d >> 2) == q : q == 0) { float v0 = 0.f, v1 = 0.f; if (d >= 0) { v0 = KT[(d * 16 + o) * 16 + i]; v1 = KT[(d * 16 + o) * 16 + i + 1]; }
            *(unsigned*)(TM + (size_t)nn * 256 + kk) = pk2(v0, v1); } }
    for (int e = tid; e < 32 * 128; e += NTHR) { const int rr = 32 * q + (e >> 7), kk = 2 * (e & 127), n = rr >> 1, ri = rr & 1, j = kk >> 4, i = kk & 15;
        const float pr = AR[(15 - j) * 64 + n], pi = AI[(15 - j) * 64 + n];
        float v[2];
#pragma unroll
        for (int qq = 0; qq < 2; ++qq) { const float br = BBR[n * 16 + i + qq], bi = BBI[n * 16 + i + qq]; v[qq] = ri == 0 ? pr * br - pi * bi : pr * bi + pi * br; }
        *(unsigned*)(TM + (size_t)(256 + rr) * 256 + kk) = pk2(v[0], v[1]); }
    for (int e = tid; e < 64 * 64; e += NTHR) { const int nn = 64 * q + (e >> 6), n = e & 63, t = nn >> 4, o = nn & 15;
        const float cr = CR[o * 64 + n], ci = CI[o * 64 + n], pr = AR[(t + 1) * 64 + n], pi = AI[(t + 1) * 64 + n];
        *(unsigned*)(M3 + (size_t)nn * 128 + 2 * n) = pk2(cr * pr - ci * pi, -(cr * pi + ci * pr)); }
    __syncthreads();
}

template <bool WITH_DT, bool IN_BF> __device__ __forceinline__ void rmsnorm_rows(const void* X, const float* gamma, bf16_t* H, float* DT, const LAS float* wdt, int gw, int NGW, int lane) {
    lane = opq(lane);
    f32x4 g[4];
#pragma unroll
    for (int j = 0; j < 4; ++j) g[j] = *(const f32x4*)(gamma + 4 * lane + 256 * j);
    for (int m = gw; m < MTOK; m += 4 * NGW) {
        f32x4 v[4][4]; float s[4];
#pragma unroll
        for (int r = 0; r < 4; ++r) { const size_t xo = (size_t)(m + r * NGW) * DM + 4 * lane; s[r] = 0.f;
#pragma unroll
            for (int j = 0; j < 4; ++j) {
                if (IN_BF) { const u32x2 w = *(const u32x2*)((const bf16_t*)X + xo + 256 * j); v[r][j] = (f32x4){bf_lo(w.x), bf_hi(w.x), bf_lo(w.y), bf_hi(w.y)}; }
                else v[r][j] = *(const f32x4*)((const float*)X + xo + 256 * j);
                s[r] += (v[r][j].x * v[r][j].x + v[r][j].y * v[r][j].y) + (v[r][j].z * v[r][j].z + v[r][j].w * v[r][j].w); } }
#pragma unroll
        for (int r = 0; r < 4; ++r) {
            const float rinv = 1.f / sqrtf(wave_sum(s[r]) * (1.f / DM) + 1e-6f);
            bf16_t* hr = H + (size_t)(m + r * NGW) * DM + 4 * lane;
#pragma unroll
            for (int j = 0; j < 4; ++j) { v[r][j] = v[r][j] * rinv * g[j]; u32x2 o; o.x = pk2(v[r][j].x, v[r][j].y); o.y = pk2(v[r][j].z, v[r][j].w); *(u32x2*)(hr + 256 * j) = o; }
            if (WITH_DT) {
                float d[8];
#pragma unroll
                for (int q = 0; q < 8; ++q) { d[q] = 0.f;
#pragma unroll
                    for (int j = 0; j < 4; ++j) { const f32x4 w = *(const LAS f32x4*)(wdt + q * 1024 + 4 * lane + 256 * j); d[q] += (v[r][j].x * w.x + v[r][j].y * w.y) + (v[r][j].z * w.z + v[r][j].w * w.w); } }
#pragma unroll
                for (int q = 0; q < 8; ++q) d[q] = wave_sum(d[q]);
                if (lane == 0) { *(f32x4*)(DT + (size_t)(m + r * NGW) * 8) = (f32x4){d[0], d[1], d[2], d[3]}; *(f32x4*)(DT + (size_t)(m + r * NGW) * 8 + 4) = (f32x4){d[4], d[5], d[6], d[7]}; }
            }
        }
    }
}

__device__ __forceinline__ void phase_prep(KArgs ap_, int l, const void* X, LAS unsigned char* lds, int tid, int lane, int wave) {
    KArgs ap = ap_; asm volatile("" : "+s"(ap)); KArgsRef a = *ap; tid = opq(tid); lane = opq(lane);
    unsigned char* ws = a.ws;
    if ((int)blockIdx.x < 128) s5_prep(ap, l, blockIdx.x >> 2, blockIdx.x & 3, lds, tid);
    LAS float* scr = (LAS float*)(lds + wave * 8448);
    const int gw = blockIdx.x * NWAVES + wave, NGW = gridDim.x * NWAVES;
    const float* w_in = a.in[2] + (size_t)l * DM * IN_COLS;
    constexpr int I_WIN = 16 * 120, I_WG = 16 * 96, I_P = 8 * 32, I_GLU = 8 * 16, I_WOUT = 16 * 32, I_FIN = 16 * 176, I_FOUT = 44 * 32, I_UP = 16, I_GUP = 32;
    constexpr int NITEMS = I_WIN + I_WG + 3 * I_P + I_GLU + I_WOUT + I_FIN + I_FOUT + 2 * I_UP + I_GUP;
    const int NGWT = 3 * 128 * NWAVES;
    const int gwt = (int)blockIdx.x >= 128 ? ((int)blockIdx.x - 128) * NWAVES + wave : 2 * 128 * NWAVES + (int)blockIdx.x * NWAVES + wave;
    const int nslot = (int)blockIdx.x >= 128 ? 2 : 1;
    for (int sl = 0; sl < nslot; ++sl)
    for (int it = gwt + sl * 128 * NWAVES; it < NITEMS; it += NGWT) {
        int r = it;
        if (r < I_WIN) { const int kb = r / 120, nb = r % 120, n0 = 32 * nb, c0 = n0 < 3328 ? n0 : n0 + 8; tr_item(w_in, IN_COLS, 64 * kb, c0, (bf16_t*)(ws + WS_WIN), 1024, n0, scr, lane); continue; } r -= I_WIN;
        if (r < I_WG) { const int kb = r / 96, nb = r % 96, n0 = 32 * nb; tr_item(w_in, IN_COLS, 64 * kb, 3848 + n0, (bf16_t*)(ws + WS_WG), 1024, n0, scr, lane); continue; } r -= I_WG;
        if (r < I_P) { tr_item(a.in[14] + (size_t)l * 512 * 1024, 1024, 64 * (r / 32), 32 * (r % 32), (bf16_t*)(ws + WS_PA), 512, 32 * (r % 32), scr, lane); continue; } r -= I_P;
        if (r < I_P) { tr_item(a.in[21] + (size_t)l * 512 * 1024, 1024, 64 * (r / 32), 32 * (r % 32), (bf16_t*)(ws + WS_PB), 512, 32 * (r % 32), scr, lane); continue; } r -= I_P;
        if (r < I_P) { tr_item(a.in[32] + (size_t)l * 512 * 1024, 1024, 64 * (r / 32), 32 * (r % 32), (bf16_t*)(ws + WS_PC), 512, 32 * (r % 32), scr, lane); continue; } r -= I_P;
        if (r < I_GLU) { tr_item(a.in[30] + (size_t)l * 512 * 512, 512, 64 * (r / 16), 32 * (r % 16), (bf16_t*)(ws + WS_GLU), 512, 32 * (r % 16), scr, lane); continue; } r -= I_GLU;
        if (r < I_WOUT) { tr_item(a.in[33] + (size_t)l * 1024 * 1024, 1024, 64 * (r / 32), 32 * (r % 32), (bf16_t*)(ws + WS_WOUT), 1024, 32 * (r % 32), scr, lane); continue; } r -= I_WOUT;
        if (r < I_FIN) { const int kb = r / 176, nb = r % 176, c0 = ((nb >> 2) & 1) * FFH + 128 * (nb >> 3) + 32 * (nb & 3);
            tr_item(a.in[35] + (size_t)l * 1024 * 2 * FFH, 2 * FFH, 64 * kb, c0, (bf16_t*)(ws + WS_FIN), 1024, 32 * nb, scr, lane); continue; } r -= I_FIN;
        if (r < I_FOUT) { tr_item(a.in[36] + (size_t)l * FFH * 1024, 1024, 64 * (r / 32), 32 * (r % 32), (bf16_t*)(ws + WS_FOUT), FFH, 32 * (r % 32), scr, lane); continue; } r -= I_FOUT;
        if (r < I_UP) { tr_item(a.in[5] + (size_t)l * 64 * 512, 512, 0, 32 * r, (bf16_t*)(ws + WS_WUP), 64, 32 * r, scr, lane); continue; } r -= I_UP;
        if (r < I_UP) { tr_item(a.in[7] + (size_t)l * 64 * 512, 512, 0, 32 * r, (bf16_t*)(ws + WS_AUP), 64, 32 * r, scr, lane); continue; } r -= I_UP;
        tr_item(a.in[8] + (size_t)l * 128 * 512, 512, 64 * (r / 16), 32 * (r % 16), (bf16_t*)(ws + WS_GUP), 128, 32 * (r % 16), scr, lane);
    }
    __syncthreads();
    LAS float* wdt = (LAS float*)lds;
    for (int e = tid; e < 8192; e += NTHR) { const int k = e >> 3, q = e & 7; wdt[q * 1024 + k] = w_in[(size_t)k * IN_COLS + 3328 + q]; }
    __syncthreads();
    if (l == 0) rmsnorm_rows<true, false>(X, a.in[1] + l * DM, (bf16_t*)(ws + WS_H), (float*)(ws + WS_DT), wdt, gw, NGW, lane);
    else rmsnorm_rows<true, true>(X, a.in[1] + l * DM, (bf16_t*)(ws + WS_H), (float*)(ws + WS_DT), wdt, gw, NGW, lane);
    __syncthreads();
}

constexpr int R_CT = 16, R_NCH = SEQ / R_CT;
constexpr int R_BW = 0, R_BA = 9216, R_BG = 18432, R_AW = 35840, R_AA = 38144, R_AG = 40448, R_VEC2 = 44800, R_VEC3 = 85760, R_BON = 110336, R_INV = 111104, R_OB = 111168;
struct StepV { f32x4 n0, n1, w0, w1, b0, b1, k0, k1, r0, r1; f32x2 vv; };
__device__ __forceinline__ StepV rw_load(const LAS float* v2, const LAS float* vvb, int t, int jj, int rp) {
    StepV s; const LAS float* p = v2 + t * 64 + 8 * jj;
    s.n0 = *(const LAS f32x4*)(p); s.n1 = *(const LAS f32x4*)(p + 4);
    s.w0 = *(const LAS f32x4*)(p + 1024); s.w1 = *(const LAS f32x4*)(p + 1028);
    s.b0 = *(const LAS f32x4*)(p + 2048); s.b1 = *(const LAS f32x4*)(p + 2052);
    s.k0 = *(const LAS f32x4*)(p + 3072); s.k1 = *(const LAS f32x4*)(p + 3076);
    s.r0 = *(const LAS f32x4*)(p + 4096); s.r1 = *(const LAS f32x4*)(p + 4100);
    s.vv = *(const LAS f32x2*)(vvb + t * 64 + 2 * rp);
    return s;
}
template <int CTRL> __device__ __forceinline__ float dppb(float x) { return __builtin_bit_cast(float, __builtin_amdgcn_update_dpp(0, __builtin_bit_cast(int, x), CTRL, 0xf, 0xf, true)); }
__device__ __forceinline__ float red8b(float x) { x += dppb<0xB1>(x); x += dppb<0x4E>(x); x += dppb<0x141>(x); return x; }
__device__ __forceinline__ void rw_step(f32x2 (&S)[8], const StepV& s, LAS float* ob, int t, int jj, int rp) {
    const f32x2 nA[4] = {{s.n0.x, s.n0.y}, {s.n0.z, s.n0.w}, {s.n1.x, s.n1.y}, {s.n1.z, s.n1.w}};
    const f32x2 wA[4] = {{s.w0.x, s.w0.y}, {s.w0.z, s.w0.w}, {s.w1.x, s.w1.y}, {s.w1.z, s.w1.w}};
    const f32x2 bA[4] = {{s.b0.x, s.b0.y}, {s.b0.z, s.b0.w}, {s.b1.x, s.b1.y}, {s.b1.z, s.b1.w}};
    const f32x2 kA[4] = {{s.k0.x, s.k0.y}, {s.k0.z, s.k0.w}, {s.k1.x, s.k1.y}, {s.k1.z, s.k1.w}};
    const f32x2 rA[4] = {{s.r0.x, s.r0.y}, {s.r0.z, s.r0.w}, {s.r1.x, s.r1.y}, {s.r1.z, s.r1.w}};
    f32x2 a0 = S[0] * nA[0], a1 = S[4] * nA[0];
#pragma unroll
    for (int i = 1; i < 4; ++i) { a0 += S[i] * nA[i]; a1 += S[4 + i] * nA[i]; }
    float sa0 = red8b(a0.x + a0.y), sa1 = red8b(a1.x + a1.y);
    const float v0 = s.vv.x, v1 = s.vv.y;
#pragma unroll
    for (int i = 0; i < 4; ++i) { S[i] = S[i] * wA[i] + (bA[i] * sa0 + kA[i] * v0); S[4 + i] = S[4 + i] * wA[i] + (bA[i] * sa1 + kA[i] * v1); }
    f32x2 o0 = S[0] * rA[0], o1 = S[4] * rA[0];
#pragma unroll
    for (int i = 1; i < 4; ++i) { o0 += S[i] * rA[i]; o1 += S[4 + i] * rA[i]; }
    f32x2 o; o.x = red8b(o0.x + o0.y); o.y = red8b(o1.x + o1.y);
    if (jj == 0) *(LAS f32x2*)(ob + t * 64 + 2 * rp) = o;
}
__device__ __forceinline__ void rwkv_unit(KArgs ap_, int l, int b, int h, LAS unsigned char* lds, int tid, int lane, int wave) {
    KArgs ap = ap_; asm volatile("" : "+s"(ap)); KArgsRef a = *ap; tid = opq(tid); lane = opq(lane);
    unsigned char* ws = a.ws;
    const bf16_t* proj = (const bf16_t*)(ws + WS_PROJ);
    bf16_t* Ya = (bf16_t*)(ws + WS_YA);
    LAS bf16_t* BW = (LAS bf16_t*)(lds + R_BW); LAS bf16_t* BA = (LAS bf16_t*)(lds + R_BA); LAS bf16_t* BG = (LAS bf16_t*)(lds + R_BG);
    LAS bf16_t* AW = (LAS bf16_t*)(lds + R_AW); LAS bf16_t* AA = (LAS bf16_t*)(lds + R_AA); LAS bf16_t* AG = (LAS bf16_t*)(lds + R_AG);
    LAS float* VEC2 = (LAS float*)(lds + R_VEC2);
    LAS float* VEC3 = (LAS float*)(lds + R_VEC3);
    LAS float* BONP = (LAS float*)(lds + R_BON);
    LAS float* INV = (LAS float*)(lds + R_INV);
    LAS float* OBB = (LAS float*)(lds + R_OB);
    const float* mu = a.in[3] + l * 1792;
    const float* w0 = a.in[4] + l * 512 + 64 * h; const float* a0 = a.in[6] + l * 512 + 64 * h;
    const float* k_k = a.in[9] + l * 512 + 64 * h; const float* k_a = a.in[10] + l * 512 + 64 * h; const float* r_k = a.in[11] + l * 512 + 64 * h;
    const float* ln_g = a.in[12] + l * 512 + 64 * h; const float* ln_b = a.in[13] + l * 512 + 64 * h;
    { const bf16_t* wup = (const bf16_t*)(ws + WS_WUP) + (size_t)64 * h * 64; const bf16_t* aup = (const bf16_t*)(ws + WS_AUP) + (size_t)64 * h * 64; const bf16_t* gup = (const bf16_t*)(ws + WS_GUP) + (size_t)64 * h * 128;
      { const int n = tid >> 3, c = tid & 7; *(LAS u32x4*)(BW + n * 72 + 8 * c) = *(const u32x4*)(wup + n * 64 + 8 * c); *(LAS u32x4*)(BA + n * 72 + 8 * c) = *(const u32x4*)(aup + n * 64 + 8 * c); }
      for (int e = tid; e < 1024; e += NTHR) { const int n = e >> 4, c = e & 15; *(LAS u32x4*)(BG + n * 136 + 8 * c) = *(const u32x4*)(gup + n * 128 + 8 * c); } }
    const bool is_scan = wave < 4;
    const size_t rowbase = (size_t)b * SEQ;
    f32x2 S[8];
#pragma unroll
    for (int i = 0; i < 8; ++i) S[i] = (f32x2){0.f, 0.f};
    const int rp = (tid >> 3) & 31, jj = tid & 7;
    const int pt = tid & 255, pw = wave & 3;
    u32x4 RC[4], RP[4];
#pragma unroll
    for (int i = 0; i < 4; ++i) { RC[i] = (u32x4){0u, 0u, 0u, 0u}; RP[i] = (u32x4){0u, 0u, 0u, 0u}; }
    __syncthreads();

#define RW_LD(IDX, KIND, tok, colv, lcv, MU, DSTF, DSTB, LDB) do { \
    const int t_ = (cn_) * R_CT + (tok); const bf16_t* pr_ = proj + (rowbase + t_) * NPROJ + (colv); \
    RC[IDX] = *(const u32x4*)pr_; RP[IDX] = t_ > 0 ? *(const u32x4*)(pr_ - NPROJ) : (u32x4){0u, 0u, 0u, 0u}; } while (0)
#define RW_PAIR(IDX, KIND, tok, colv, lcv, MU, DSTF, DSTB, LDB) do { \
    float cur_[8], prv_[8], v_[8]; unpack8(RC[IDX], cur_); unpack8(RP[IDX], prv_); \
    { const f32x4 m0_ = *(const f32x4*)(mu + (colv)), m1_ = *(const f32x4*)(mu + (colv) + 4); \
      _Pragma("unroll") for (int e = 0; e < 4; ++e) { v_[e] = cur_[e] + (prv_[e] - cur_[e]) * m0_[e]; v_[4 + e] = cur_[4 + e] + (prv_[4 + e] - cur_[4 + e]) * m1_[e]; } } \
    if (KIND <= 2) { LAS float* d_ = (DSTF) + (tok) * 64 + (lcv); *(LAS f32x4*)d_ = (f32x4){v_[0], v_[1], v_[2], v_[3]}; *(LAS f32x4*)(d_ + 4) = (f32x4){v_[4], v_[5], v_[6], v_[7]}; \
        if (KIND == 1) { const f32x4 k0_ = *(const f32x4*)(k_k + (lcv)), k1_ = *(const f32x4*)(k_k + (lcv) + 4); float q_ = 0.f; _Pragma("unroll") for (int e = 0; e < 4; ++e) { const float x_ = v_[e] * k0_[e], y_ = v_[4 + e] * k1_[e]; q_ += x_ * x_ + y_ * y_; } q_ = red8b(q_); if (((lcv) >> 3) == 0) INV[tok] = __builtin_amdgcn_rsqf(fmaxf(q_, 1e-24f)); } } \
    else { if (KIND == 3) { _Pragma("unroll") for (int e = 0; e < 8; ++e) v_[e] = ftanh(v_[e]); } \
        if (KIND == 5) { _Pragma("unroll") for (int e = 0; e < 8; ++e) v_[e] = sigm(v_[e]); } \
        *(LAS u32x4*)((DSTB) + (tok) * (LDB) + (lcv)) = pack8(v_); } } while (0)
#define RW_FORPAIRS(OP) do { const int ln = opq(lane); \
    if (pw == 0) { _Pragma("unroll") for (int i = 0; i < 2; ++i) { const int tok = (ln >> 3) + 8 * i, lc = 8 * (ln & 7); \
            OP(2 * i, 3, tok, P_WD + lc, lc, muA, v2, AW, 72); OP(2 * i + 1, 4, tok, P_AD + lc, lc, muB, v2, AA, 72); } } \
    else if (pw == 1) { _Pragma("unroll") for (int i = 0; i < 2; ++i) { const int tok = (ln >> 4) + 4 * i, lc = 8 * (ln & 15), tok2 = (ln >> 3) + 8 * i, lc2 = 8 * (ln & 7); \
            OP(2 * i, 5, tok, P_GD + lc, lc, muA, v2, AG, 136); OP(2 * i + 1, 0, tok2, P_R + 64 * h + lc2, lc2, muB, v2 + 4096, AW, 72); } } \
    else if (pw == 2) { _Pragma("unroll") for (int i = 0; i < 2; ++i) { const int tok = 8 + (ln >> 4) + 4 * i, lc = 8 * (ln & 15), tok2 = (ln >> 3) + 8 * i, lc2 = 8 * (ln & 7); \
            OP(2 * i, 5, tok, P_GD + lc, lc, muA, v2, AG, 136); OP(2 * i + 1, 2, tok2, P_V + 64 * h + lc2, lc2, muB, v3, AW, 72); } } \
    else { _Pragma("unroll") for (int i = 0; i < 2; ++i) { const int tok = (ln >> 3) + 8 * i, lc = 8 * (ln & 7); \
            OP(i, 1, tok, P_K + 64 * h + lc, lc, muA, v2 + 3072, AW, 72); } } \
    } while (0)
#define RW_LOAD(cn) do { const int cn_ = (cn); LAS float* v2 = nullptr; LAS float* v3 = nullptr; (void)v2; (void)v3; RW_FORPAIRS(RW_LD); } while (0)
#define RW_PREP1(cn) do { const int cn_ = (cn); (void)cn_; \
    LAS float* v2 = VEC2 + (cn_ & 1) * 5120; LAS float* v3 = VEC3 + (cn_ % 3) * 2048; RW_FORPAIRS(RW_PAIR); } while (0)

#define RW_PREP2(cn) do { const int ln2 = opq(lane); const int r16 = ln2 & 15, q4 = ln2 >> 4, kq = 8 * q4, nn = 16 * pw + r16; \
    const float w0n = w0[nn], a0n = a0[nn], kkn = k_k[nn], kan = k_a[nn], rkn = r_k[nn]; \
    LAS float* v2 = VEC2 + ((cn) & 1) * 5120; LAS float* v3 = VEC3 + ((cn) % 3) * 2048; LAS float* bp = BONP + ((cn) % 3) * 64; \
    const f32x4 z4_ = {0.f, 0.f, 0.f, 0.f}; \
    f32x4 cw = MFMA16(ldsfrag(AW, r16, 72, kq), ldsfrag(BW, 16 * pw + r16, 72, kq), z4_); cw = MFMA16(ldsfrag(AW, r16, 72, 32 + kq), ldsfrag(BW, 16 * pw + r16, 72, 32 + kq), cw); \
    f32x4 ca = MFMA16(ldsfrag(AA, r16, 72, kq), ldsfrag(BA, 16 * pw + r16, 72, kq), z4_); ca = MFMA16(ldsfrag(AA, r16, 72, 32 + kq), ldsfrag(BA, 16 * pw + r16, 72, 32 + kq), ca); \
    f32x4 cgt = MFMA16(ldsfrag(AG, r16, 136, kq), ldsfrag(BG, 16 * pw + r16, 136, kq), z4_); \
    _Pragma("unroll") for (int ks = 1; ks < 4; ++ks) cgt = MFMA16(ldsfrag(AG, r16, 136, 32 * ks + kq), ldsfrag(BG, 16 * pw + r16, 136, 32 * ks + kq), cgt); \
    _Pragma("unroll") for (int j = 0; j < 4; ++j) { const int tok = 4 * q4 + j; \
        const float wv = __expf(-0.6065306597f * sigm(w0n + cw[j])); const float av = sigm(a0n + ca[j]); \
        const float kr = v2[3072 + tok * 64 + nn], rr = v2[4096 + tok * 64 + nn], inv = INV[tok]; \
        const float kk = kr * kkn * inv, kp = kr * (1.f + (av - 1.f) * kan); \
        v2[tok * 64 + nn] = -kk; v2[1024 + tok * 64 + nn] = wv; v2[2048 + tok * 64 + nn] = kk * av; v2[3072 + tok * 64 + nn] = kp; \
        v3[1024 + tok * 64 + nn] = cgt[j]; \
        float bs = rr * kp * rkn; bs = red16(bs); if (r16 == 0) bp[tok * 4 + pw] = bs; } \
    } while (0)

#define RW_FIN(cf) do { \
    const LAS float* ob = OBB + ((cf) & 1) * 1024; const LAS float* v3 = VEC3 + ((cf) % 3) * 2048; const LAS float* bp = BONP + ((cf) % 3) * 64; \
    const int pt_ = opq(pt); const int tok = pt_ >> 4, sub = pt_ & 15, n0 = 4 * sub; \
    const f32x4 o = *(const LAS f32x4*)(ob + tok * 64 + n0); \
    float s = (o.x + o.y) + (o.z + o.w); s = red16(s); \
    const float mean = s * (1.f / 64.f); const f32x4 d = o - mean; \
    float q = (d.x * d.x + d.y * d.y) + (d.z * d.z + d.w * d.w); q = red16(q); \
    const float rstd = __builtin_amdgcn_rsqf(q * (1.f / 64.f) + 64e-5f); \
    const f32x4 lg = *(const f32x4*)(ln_g + n0), lb = *(const f32x4*)(ln_b + n0); \
    const f32x4 vv = *(const LAS f32x4*)(v3 + tok * 64 + n0), gg = *(const LAS f32x4*)(v3 + 1024 + tok * 64 + n0); \
    const f32x4 bq = *(const LAS f32x4*)(bp + tok * 4); const float bon = (bq.x + bq.y) + (bq.z + bq.w); \
    const f32x4 y = (d * rstd * lg + lb + vv * bon) * gg; \
    u32x2 w; w.x = pk2(y.x, y.y); w.y = pk2(y.z, y.w); \
    *(u32x2*)(Ya + (rowbase + (cf) * R_CT + tok) * 512 + 64 * h + n0) = w; } while (0)

#define RW_SCAN8(c, t0) do { \
    const int a2_ = opq(R_VEC2 + ((c) & 1) * 20480 + 32 * jj), a3_ = opq(R_VEC3 + ((c) % 3) * 8192 + 8 * rp), ao_ = opq(R_OB + ((c) & 1) * 4096 + 8 * rp); \
    const LAS float* v2 = (const LAS float*)(lds + a2_); const LAS float* vvb = (const LAS float*)(lds + a3_); LAS float* ob = (LAS float*)(lds + ao_); \
    StepV cur = rw_load(v2, vvb, (t0), 0, 0); \
    _Pragma("unroll") for (int i = 0; i < 8; ++i) { StepV nxt; if (i < 7) nxt = rw_load(v2, vvb, (t0) + i + 1, 0, 0); \
        rw_step(S, cur, ob, (t0) + i, jj, 0); if (i < 7) cur = nxt; } } while (0)

    if (!is_scan) { RW_LOAD(0); RW_PREP1(0); RW_LOAD(1); }
    __syncthreads();
    if (!is_scan) RW_PREP2(0);
    __syncthreads();
#pragma unroll 1
    for (int c = 0; c < R_NCH; ++c) {
        if (is_scan) { RW_SCAN8(c, 0); } else { if (c + 1 < R_NCH) RW_PREP1(c + 1); if (c + 2 < R_NCH) RW_LOAD(c + 2); }
        __syncthreads();
        if (is_scan) { RW_SCAN8(c, 8); } else { if (c + 1 < R_NCH) RW_PREP2(c + 1); if (c >= 1) RW_FIN(c - 1); }
        __syncthreads();
    }
    if (!is_scan) RW_FIN(R_NCH - 1);
    __syncthreads();
#undef RW_PREP1
#undef RW_LOAD
#undef RW_LD
#undef RW_PAIR
#undef RW_FORPAIRS
#undef RW_PREP2
#undef RW_FIN
#undef RW_SCAN8
}

constexpr int S_LD = 136;
constexpr int S_CS = 0, S_BS = 34816, S_BT = 69632, S_XT = 104448, S_SB = 121856, S_ACS = 139264, S_DTV = 139776;
__device__ __forceinline__ void ssd_unit(KArgs ap_, int l, int b, int h, LAS unsigned char* lds, int tid, int lane, int wave) {
    KArgs ap = ap_; asm volatile("" : "+s"(ap)); KArgsRef a = *ap; tid = opq(tid); lane = opq(lane);
    unsigned char* ws = a.ws;
    const bf16_t* proj = (const bf16_t*)(ws + WS_PROJ);
    const float* dtraw = (const float*)(ws + WS_DT);
    bf16_t* Yb = (bf16_t*)(ws + WS_YB);
    LAS bf16_t* Cs = (LAS bf16_t*)(lds + S_CS); LAS bf16_t* Bs = (LAS bf16_t*)(lds + S_BS); LAS bf16_t* BT = (LAS bf16_t*)(lds + S_BT);
    LAS bf16_t* XT = (LAS bf16_t*)(lds + S_XT); LAS bf16_t* SB = (LAS bf16_t*)(lds + S_SB);
    LAS float* ACS = (LAS float*)(lds + S_ACS); LAS float* DTV = (LAS float*)(lds + S_DTV);
    const int g = h >> 2;
    const float* cw = a.in[15] + (size_t)l * 4 * 1024; const float* cb = a.in[16] + l * 1024;
    const float dtb = a.in[17][l * 8 + h], Ah = -expf(a.in[18][l * 8 + h]), Dh = a.in[19][l * 8 + h];
    const size_t rowbase = (size_t)b * SEQ;
    const int r16 = lane & 15, q4 = lane >> 4, kq = 8 * q4;
    f32x4 st[4];
#pragma unroll
    for (int i = 0; i < 4; ++i) st[i] = (f32x4){0.f, 0.f, 0.f, 0.f};
    for (int e = tid; e < 64 * S_LD / 2; e += NTHR) ((LAS unsigned*)SB)[e] = 0u;
    __syncthreads();
    for (int t0 = 0; t0 < SEQ; t0 += 128) {
        if (tid < 128) DTV[tid] = softplusf(dtraw[(rowbase + t0 + tid) * 8 + h] + dtb);
        __syncthreads();
        if (wave == 0) { const float a0 = DTV[2 * lane] * Ah, a1 = DTV[2 * lane + 1] * Ah; float s = a0 + a1;
#pragma unroll
            for (int o = 1; o < 64; o <<= 1) { const float t = __shfl_up(s, o); if (lane >= o) s += t; }
            ACS[2 * lane + 1] = s; ACS[2 * lane] = s - a1; }
        __syncthreads();
        const float acsL = ACS[127];
        for (int item = tid; item < 640; item += NTHR) {
            const int tg = item / 40, vec = item % 40, l0 = 8 * tg;
            int col, kind, lc;
            if (vec < 8) { kind = 0; lc = 8 * vec; col = P_XS + 64 * h + lc; }
            else if (vec < 24) { kind = 1; lc = 8 * (vec - 8); col = P_B + 128 * g + lc; }
            else { kind = 2; lc = 8 * (vec - 24); col = P_C + 128 * g + lc; }
            const int cc = col - P_XS;
            u32x4 in[11];
#pragma unroll
            for (int i = 0; i < 11; ++i) { const int t = t0 + l0 - 3 + i; in[i] = t >= 0 ? *(const u32x4*)(proj + (rowbase + t) * NPROJ + col) : (u32x4){0u, 0u, 0u, 0u}; }
            float wj[4][8], bias[8];
#pragma unroll
            for (int j = 0; j < 4; ++j) { const f32x4 x0 = *(const f32x4*)(cw + j * 1024 + cc), x1 = *(const f32x4*)(cw + j * 1024 + cc + 4);
                wj[j][0] = x0.x; wj[j][1] = x0.y; wj[j][2] = x0.z; wj[j][3] = x0.w; wj[j][4] = x1.x; wj[j][5] = x1.y; wj[j][6] = x1.z; wj[j][7] = x1.w; }
            { const f32x4 x0 = *(const f32x4*)(cb + cc), x1 = *(const f32x4*)(cb + cc + 4); bias[0] = x0.x; bias[1] = x0.y; bias[2] = x0.z; bias[3] = x0.w; bias[4] = x1.x; bias[5] = x1.y; bias[6] = x1.z; bias[7] = x1.w; }
            float out[8][8];
#pragma unroll
            for (int tt = 0; tt < 8; ++tt)
#pragma unroll
                for (int e = 0; e < 8; ++e) out[tt][e] = bias[e];
#pragma unroll
            for (int i = 0; i < 11; ++i) { float x[8]; unpack8(in[i], x);
#pragma unroll
                for (int j = 0; j < 4; ++j) { const int tt = i - j;
                    if (tt >= 0 && tt < 8) {
#pragma unroll
                        for (int e = 0; e < 8; ++e) out[tt][e] += wj[j][e] * x[e]; } } }
#pragma unroll
            for (int tt = 0; tt < 8; ++tt)
#pragma unroll
                for (int e = 0; e < 8; ++e) out[tt][e] = out[tt][e] * sigm(out[tt][e]);
            if (kind == 0) {
                float dtl[8];
#pragma unroll
                for (int tt = 0; tt < 8; ++tt) dtl[tt] = DTV[l0 + tt];
#pragma unroll
                for (int e = 0; e < 8; ++e) { float c[8];
#pragma unroll
                    for (int tt = 0; tt < 8; ++tt) c[tt] = out[tt][e] * dtl[tt];
                    *(LAS u32x4*)(XT + (lc + e) * S_LD + l0) = pack8(c); }
            } else if (kind == 1) {
                float dec[8];
#pragma unroll
                for (int tt = 0; tt < 8; ++tt) dec[tt] = __expf(acsL - ACS[l0 + tt]);
#pragma unroll
                for (int tt = 0; tt < 8; ++tt) *(LAS u32x4*)(Bs + (l0 + tt) * S_LD + lc) = pack8(out[tt]);
#pragma unroll
                for (int e = 0; e < 8; ++e) { float c[8];
#pragma unroll
                    for (int tt = 0; tt < 8; ++tt) c[tt] = out[tt][e] * dec[tt];
                    *(LAS u32x4*)(BT + (lc + e) * S_LD + l0) = pack8(c); }
            } else {
#pragma unroll
                for (int tt = 0; tt < 8; ++tt) *(LAS u32x4*)(Cs + (l0 + tt) * S_LD + lc) = pack8(out[tt]);
            }
        }
        __syncthreads();
        f32x4 sc[8];
#pragma unroll
        for (int i = 0; i < 8; ++i) sc[i] = (f32x4){0.f, 0.f, 0.f, 0.f};
#pragma unroll
        for (int ks = 0; ks < 4; ++ks) { const bf16x8 af = ldsfrag(Cs, 16 * wave + r16, S_LD, 32 * ks + kq);
#pragma unroll
            for (int s = 0; s < 8; ++s) sc[s] = MFMA16(af, ldsfrag(Bs, 16 * s + r16, S_LD, 32 * ks + kq), sc[s]); }
        __syncthreads();
        {
            float al[4], dl[4];
#pragma unroll
            for (int j = 0; j < 4; ++j) { al[j] = ACS[16 * wave + 4 * q4 + j]; dl[j] = Dh / DTV[16 * wave + 4 * q4 + j]; }
#pragma unroll
            for (int s = 0; s < 8; ++s) { const int sidx = 16 * s + r16; const float as = ACS[sidx];
#pragma unroll
                for (int j = 0; j < 4; ++j) { const int lidx = 16 * wave + 4 * q4 + j;
                    float v = sidx <= lidx ? sc[s][j] * __expf(al[j] - as) : 0.f; if (sidx == lidx) v += dl[j];
                    Bs[lidx * S_LD + sidx] = (bf16_t)f2bf(v); } }
        }
        __syncthreads();
        {
            f32x4 yd[4], yo[4];
#pragma unroll
            for (int i = 0; i < 4; ++i) { yd[i] = (f32x4){0.f, 0.f, 0.f, 0.f}; yo[i] = (f32x4){0.f, 0.f, 0.f, 0.f}; }
#pragma unroll
            for (int ks = 0; ks < 4; ++ks) { const bf16x8 am = ldsfrag(Bs, 16 * wave + r16, S_LD, 32 * ks + kq), ac = ldsfrag(Cs, 16 * wave + r16, S_LD, 32 * ks + kq);
#pragma unroll
                for (int pt = 0; pt < 4; ++pt) { yd[pt] = MFMA16(am, ldsfrag(XT, 16 * pt + r16, S_LD, 32 * ks + kq), yd[pt]);
                    yo[pt] = MFMA16(ac, ldsfrag(SB, 16 * pt + r16, S_LD, 32 * ks + kq), yo[pt]); } }
#pragma unroll
            for (int j = 0; j < 4; ++j) { const int lidx = 16 * wave + 4 * q4 + j; const float ea = __expf(ACS[lidx]);
                const size_t row = rowbase + t0 + lidx;
#pragma unroll
                for (int pt = 0; pt < 4; ++pt) { const int p = 16 * pt + r16;
                    const float z = bf2f(proj[row * NPROJ + P_Z + 64 * h + p]);
                    const float y = (yd[pt][j] + ea * yo[pt][j]) * (z * sigm(z));
                    Yb[row * 512 + 64 * h + p] = (bf16_t)f2bf(y); } }
        }
        {
            const float dec = __expf(acsL);
#pragma unroll
            for (int pt = 0; pt < 4; ++pt) st[pt] = st[pt] * dec;
#pragma unroll
            for (int ks = 0; ks < 4; ++ks) { const bf16x8 bf = ldsfrag(BT, 16 * wave + r16, S_LD, 32 * ks + kq);
#pragma unroll
                for (int pt = 0; pt < 4; ++pt) st[pt] = MFMA16(ldsfrag(XT, 16 * pt + r16, S_LD, 32 * ks + kq), bf, st[pt]); }
        }
        __syncthreads();
#pragma unroll
        for (int pt = 0; pt < 4; ++pt)
#pragma unroll
            for (int j = 0; j < 4; ++j) SB[(16 * pt + 4 * q4 + j) * S_LD + 16 * wave + r16] = (bf16_t)f2bf(st[pt][j]);
    }
    __syncthreads();
}

constexpr int F_U = 0, F_SP = 67584;
__device__ __forceinline__ float gelu_tanh(float x) { const float u = 0.7978845608028654f * (x + 0.044715f * x * x * x); return 0.5f * x * (1.f + ftanh(u)); }
__device__ __forceinline__ void s5_unit(KArgs ap_, int l, int b, int g, LAS unsigned char* lds, int tid, int lane, int wave) {
    KArgs ap = ap_; asm volatile("" : "+s"(ap)); KArgsRef a = *ap; tid = opq(tid); lane = opq(lane);
    unsigned char* ws = a.ws;
    const bf16_t* proj = (const bf16_t*)(ws + WS_PROJ);
    bf16_t* ZG = (bf16_t*)(ws + WS_ZG);
    const bf16_t* tm = (const bf16_t*)(ws + WS_TM) + (size_t)g * 384 * 256;
    const bf16_t* m3 = (const bf16_t*)(ws + WS_M3) + (size_t)g * 256 * 128;
    const float* A16 = (const float*)(ws + WS_A16) + g * 128;
    LAS bf16_t* U = (LAS bf16_t*)(lds + F_U); LAS float* ST = (LAS float*)(lds + F_U); LAS bf16_t* SP = (LAS bf16_t*)(lds + F_SP);
    LAS unsigned char* ZL = lds + F_U;
    const size_t rowbase = (size_t)b * SEQ;
    const int r16 = lane & 15, q4 = lane >> 4, kq = 8 * q4;
    u32x4 ur[8];
#pragma unroll
    for (int j = 0; j < 8; ++j) { const int i = tid + NTHR * j, t = i >> 1, hf = i & 1; ur[j] = *(const u32x4*)(proj + (rowbase + t) * NPROJ + P_U + 16 * g + 8 * hf); }
    bf16x8 bf[8][3];
#pragma unroll
    for (int ks = 0; ks < 4; ++ks) { const int k = 32 * ks + kq;
        bf[ks][0] = *(const bf16x8*)(tm + (size_t)(32 * wave + r16) * 256 + k); bf[ks][1] = *(const bf16x8*)(tm + (size_t)(32 * wave + 16 + r16) * 256 + k); bf[ks][2] = *(const bf16x8*)(tm + (size_t)(256 + 16 * wave + r16) * 256 + k); }
#pragma unroll
    for (int j = 0; j < 8; ++j) { const int i = tid + NTHR * j, t = i >> 1, hf = i & 1; *(LAS u32x4*)(U + (t >> 4) * 264 + (t & 15) * 16 + 8 * hf) = ur[j]; }
    asm volatile("" ::: "memory");
#pragma unroll
    for (int ks = 4; ks < 8; ++ks) { const int k = 32 * ks + kq;
        bf[ks][0] = *(const bf16x8*)(tm + (size_t)(32 * wave + r16) * 256 + k); bf[ks][1] = *(const bf16x8*)(tm + (size_t)(32 * wave + 16 + r16) * 256 + k); bf[ks][2] = *(const bf16x8*)(tm + (size_t)(256 + 16 * wave + r16) * 256 + k); }
    __syncthreads();
    f32x4 ay[8][2], as_[8];
#pragma unroll
    for (int m = 0; m < 8; ++m) { ay[m][0] = (f32x4){0.f, 0.f, 0.f, 0.f}; ay[m][1] = (f32x4){0.f, 0.f, 0.f, 0.f}; as_[m] = (f32x4){0.f, 0.f, 0.f, 0.f}; }
#pragma unroll
    for (int ks = 0; ks < 8; ++ks) { const int k = 32 * ks + kq;
#pragma unroll
        for (int m = 0; m < 8; ++m) { const bf16x8 af = ldsfrag(U, 16 * m + r16, 264, k);
            ay[m][0] = MFMA16(af, bf[ks][0], ay[m][0]); ay[m][1] = MFMA16(af, bf[ks][1], ay[m][1]); as_[m] = MFMA16(af, bf[ks][2], as_[m]); } }
    bf16x8 mf[4][2];
#pragma unroll
    for (int ks = 0; ks < 4; ++ks) { const int k = 32 * ks + kq;
        mf[ks][0] = *(const bf16x8*)(m3 + (size_t)(32 * wave + r16) * 128 + k); mf[ks][1] = *(const bf16x8*)(m3 + (size_t)(32 * wave + 16 + r16) * 128 + k); }
    __syncthreads();
#pragma unroll
    for (int m = 0; m < 8; ++m)
#pragma unroll
        for (int j = 0; j < 4; ++j) ST[(16 * m + 4 * q4 + j) * 128 + 16 * wave + r16] = as_[m][j];
    __syncthreads();
    if (tid < 64) { const int n = tid; const float ar = A16[2 * n], ai = A16[2 * n + 1]; float sr = 0.f, si = 0.f;
#pragma unroll 8
        for (int c = 0; c < 128; ++c) { *(LAS unsigned*)(SP + c * 136 + 2 * n) = pk2(sr, si);
            const f32x2 t = *(LAS f32x2*)(ST + c * 128 + 2 * n);
            const float nr = ar * sr - ai * si + t.x, ni = ar * si + ai * sr + t.y; sr = nr; si = ni; } }
    __syncthreads();
#pragma unroll
    for (int ks = 0; ks < 4; ++ks) { const int k = 32 * ks + kq;
#pragma unroll
        for (int m = 0; m < 8; ++m) { const bf16x8 af = ldsfrag(SP, 16 * m + r16, 136, k);
            ay[m][0] = MFMA16(af, mf[ks][0], ay[m][0]); ay[m][1] = MFMA16(af, mf[ks][1], ay[m][1]); } }
    __syncthreads();
#pragma unroll
    for (int m = 0; m < 8; ++m)
#pragma unroll
        for (int e = 0; e < 2; ++e)
#pragma unroll
            for (int j = 0; j < 4; ++j) { const int c = 16 * m + 4 * q4 + j, tok = 16 * c + 2 * wave + e;
                *(LAS bf16_t*)(ZL + tok * 32 + c * 32 + 2 * r16) = (bf16_t)f2bf(gelu_tanh(ay[m][e][j])); }
    __syncthreads();
#pragma unroll
    for (int j = 0; j < 8; ++j) { const int i = tid + NTHR * j, t = i >> 1, hf = i & 1;
        *(u32x4*)(ZG + (rowbase + t) * 512 + 16 * g + 8 * hf) = *(const LAS u32x4*)(ZL + t * 32 + (t >> 4) * 32 + 16 * hf); }
    __syncthreads();
}

__device__ __forceinline__ void ssd_norm_rows(KArgs ap_, int l, int gw, int NGW, int lane) {
    KArgs ap = ap_; asm volatile("" : "+s"(ap)); KArgsRef a = *ap; lane = opq(lane);
    bf16_t* Yb = (bf16_t*)(a.ws + WS_YB);
    const float* ng = a.in[20] + l * 512 + 8 * lane;
    const f32x4 g0 = *(const f32x4*)ng, g1 = *(const f32x4*)(ng + 4);
    for (int m = gw; m < MTOK; m += 4 * NGW) {
        u32x4 raw[4];
#pragma unroll
        for (int r = 0; r < 4; ++r) raw[r] = *(const u32x4*)(Yb + (size_t)(m + r * NGW) * 512 + 8 * lane);
#pragma unroll
        for (int r = 0; r < 4; ++r) {
            float v[8]; unpack8(raw[r], v);
            float s = 0.f;
#pragma unroll
            for (int e = 0; e < 8; ++e) s += v[e] * v[e];
            s = red32(s);
            const float rinv = __builtin_amdgcn_rsqf(s * (1.f / 256.f) + 1e-5f);
            v[0] *= rinv * g0.x; v[1] *= rinv * g0.y; v[2] *= rinv * g0.z; v[3] *= rinv * g0.w; v[4] *= rinv * g1.x; v[5] *= rinv * g1.y; v[6] *= rinv * g1.z; v[7] *= rinv * g1.w;
            *(u32x4*)(Yb + (size_t)(m + r * NGW) * 512 + 8 * lane) = pack8(v);
        }
    }
}

__device__ __forceinline__ void final_norm_rows(const bf16_t* X, float* O, const float* gamma, int gw, int NGW, int lane) {
    lane = opq(lane);
    f32x4 g[4];
#pragma unroll
    for (int j = 0; j < 4; ++j) g[j] = *(const f32x4*)(gamma + 4 * lane + 256 * j);
    for (int m = gw; m < MTOK; m += 4 * NGW) {
        f32x4 v[4][4]; float s[4];
#pragma unroll
        for (int r = 0; r < 4; ++r) { const bf16_t* xr = X + (size_t)(m + r * NGW) * DM + 4 * lane; s[r] = 0.f;
#pragma unroll
            for (int j = 0; j < 4; ++j) { const u32x2 w = *(const u32x2*)(xr + 256 * j); v[r][j] = (f32x4){bf_lo(w.x), bf_hi(w.x), bf_lo(w.y), bf_hi(w.y)};
                s[r] += (v[r][j].x * v[r][j].x + v[r][j].y * v[r][j].y) + (v[r][j].z * v[r][j].z + v[r][j].w * v[r][j].w); } }
#pragma unroll
        for (int r = 0; r < 4; ++r) { float* xr = O + (size_t)(m + r * NGW) * DM + 4 * lane;
            const float rinv = 1.f / sqrtf(wave_sum(s[r]) * (1.f / DM) + 1e-6f);
#pragma unroll
            for (int j = 0; j < 4; ++j) *(f32x4*)(xr + 256 * j) = v[r][j] * rinv * g[j]; }
    }
}

#define XB_TMO      128
#define XB_XCNT(j)  (256  + 64 * (j))
#define XB_XSUB(j)  (1280 + 64 * (j))
#define XB_XGEN(j)  (2304 + 64 * (j))
#define XB_TOP      3328
#define XB_TOPGEN   3392
#define XCD_BAR_WORDS 3456
#define XB_SPIN_CAP (1u << 18)

__device__ __forceinline__ unsigned xb_ld(unsigned* p)              { return __hip_atomic_load(p, __ATOMIC_RELAXED, __HIP_MEMORY_SCOPE_AGENT); }
__device__ __forceinline__ unsigned xb_add(unsigned* p, unsigned v) { return __hip_atomic_fetch_add(p, v, __ATOMIC_RELAXED, __HIP_MEMORY_SCOPE_AGENT); }
__device__ __forceinline__ unsigned xb_xcc_id() { return (unsigned)__builtin_amdgcn_s_getreg((3 << 11) | 20) & 0xFu; }
#define XB_SPIN(cond, bar) do { unsigned _sp = 0; while (cond) { __builtin_amdgcn_s_sleep(1); \
    if ((++_sp & 255u) == 0u) { if (xb_ld(&(bar)[XB_TMO])) break; if (_sp > XB_SPIN_CAP) { atomicAdd(&(bar)[XB_TMO], 1u); break; } } } } while (0)

struct XcdBarrier {
    unsigned* bar; unsigned x; unsigned G;
    volatile LAS unsigned* st;
};

__device__ __forceinline__ XcdBarrier xcd_barrier_post(unsigned* bar, volatile LAS unsigned* st) {
    XcdBarrier b; b.bar = bar; b.x = xb_xcc_id(); b.st = st; b.G = gridDim.x;
    if (threadIdx.x == 0) (void)xb_add(&bar[XB_XCNT(b.x)], 1u);
    return b;
}
__device__ __forceinline__ void xcd_barrier_complete(unsigned* bar, unsigned x, unsigned G, unsigned& nloc, unsigned& nx) {
    unsigned sum, cnt, mine, sp = 0u;
    for (;;) {
        sum = 0u; cnt = 0u; mine = 0u;
#pragma unroll
        for (unsigned j = 0; j < 16; ++j) { const unsigned c = xb_ld(&bar[XB_XCNT(j)]); sum += c; cnt += (c > 0u) ? 1u : 0u; mine = (j == x) ? c : mine; }
        if (sum == G) break;
        __builtin_amdgcn_s_sleep(1);
        if ((++sp & 255u) == 0u) { if (xb_ld(&bar[XB_TMO])) break; if (sp > XB_SPIN_CAP) { atomicAdd(&bar[XB_TMO], 1u); break; } }
    }
    nloc = mine > 0u ? mine : 1u; nx = cnt > 0u ? cnt : 1u;
}

__device__ __forceinline__ void xcd_barrier(const XcdBarrier& b) {
    asm volatile("s_waitcnt vmcnt(0)" ::: "memory");
    __syncthreads();
    if (threadIdx.x == 0) {
        unsigned* bar = b.bar;
        __builtin_amdgcn_s_waitcnt(0);
        unsigned nloc = b.st[0], nx = b.st[1];
        if (nloc == 0u) { xcd_barrier_complete(bar, b.x, b.G, nloc, nx); b.st[0] = nloc; b.st[1] = nx; }
        const unsigned old = xb_add(&bar[XB_XSUB(b.x)], 1u);
        const unsigned gen = old / nloc;
        if (old + 1u == (gen + 1u) * nloc) {
            __builtin_amdgcn_fence(__ATOMIC_RELEASE, "agent");
            asm volatile("s_waitcnt vmcnt(0)" ::: "memory");
            const unsigned og = xb_add(&bar[XB_TOP], 1u);
            const unsigned tg = og / nx;
            if (og + 1u == (tg + 1u) * nx) xb_add(&bar[XB_TOPGEN], 1u);
            else XB_SPIN(xb_ld(&bar[XB_TOPGEN]) == tg, bar);
            __builtin_amdgcn_fence(__ATOMIC_ACQUIRE, "agent");
            xb_add(&bar[XB_XGEN(b.x)], 1u);
            asm volatile("s_waitcnt vmcnt(0)" ::: "memory");
        } else {
            XB_SPIN(xb_ld(&bar[XB_XGEN(b.x)]) == gen, bar);
            __builtin_amdgcn_fence(__ATOMIC_ACQUIRE, "agent");
            asm volatile("s_waitcnt vmcnt(0)" ::: "memory");
        }
    }
    __syncthreads();
}


#ifndef PHM
#define PHM 63
#endif
#define GEMM_PHASE(EPI, AOFF, BOFF, N_, K_, E_) do { pg8::Gemm g_{(const pg8::bf16_t*)(ws + (AOFF)), (const pg8::bf16_t*)(ws + (BOFF)), MTOK, (N_), (K_)}; pg8::StaticOrder S_; S_.init(MTOK, (N_), (int)gridDim.x, (int)blockIdx.x); \
    pg8::gemm_phase<EPI, pg8::StaticOrder, true, true>(lds, g_, S_, (E_)); } while (0)
#define FRESH() KArgs ap = kargs(); unsigned char* ws = ap->ws; (void)ws

__global__ void __launch_bounds__(NTHR, 2) hybrid_fwd(Args a_unused) {
    extern __shared__ __attribute__((aligned(16))) unsigned char lds_raw[];
    LAS unsigned char* lds = (LAS unsigned char*)lds_raw;
    cg::grid_group grid = cg::this_grid();
    volatile LAS unsigned* bst = (volatile LAS unsigned*)(lds + LDS_BYTES - 64);
    if (threadIdx.x < 4) bst[threadIdx.x] = 0u;
    __syncthreads();
    XcdBarrier xbar = xcd_barrier_post((unsigned*)kargs()->ws, bst);
    XcdBarrier xsub = xbar;
    if ((int)blockIdx.x >= 128) { xsub = xcd_barrier_post((unsigned*)kargs()->ws + 4096, bst + 2); xsub.G = gridDim.x - 128; }
    grid.sync();
    const int tid = threadIdx.x, lane = tid & 63, wave = __builtin_amdgcn_readfirstlane(tid >> 6);
    const int gw = blockIdx.x * NWAVES + wave, NGW = gridDim.x * NWAVES;
#pragma unroll 1
    for (int l = 0; l < DEPTH; ++l) {
        { FRESH();
#ifndef NO_PREP
          phase_prep(ap, l, l == 0 ? (const void*)ap->in[0] : (const void*)ap->out, lds, tid, lane, wave);
#endif
        }
        xcd_barrier(xbar);
        if (PHM & 1) { FRESH(); pg8::EpiStore E{(bf16_t*)(ws + WS_PROJ), NPROJ}; GEMM_PHASE(pg8::EpiStore, WS_H, WS_WIN, NPROJ, 1024, E); }
        xcd_barrier(xbar);
#ifndef REPC
#define REPC 1
#endif
#pragma unroll 1
        for (int rep = 0; rep < REPC; ++rep) { FRESH();
          if ((int)blockIdx.x < 128) {
#ifndef NO_RWKV
            rwkv_unit(ap, l, blockIdx.x >> 3, blockIdx.x & 7, lds, tid, lane, wave);
#endif
          } else { const int u = blockIdx.x - 128;
#ifndef NO_SSD
#ifndef REPS
#define REPS 1
#endif
#pragma unroll 1
            for (int rs = 0; rs < REPS; ++rs) ssd_unit(ap, l, u >> 3, u & 7, lds, tid, lane, wave);
#endif
#ifndef NO_S5
#pragma unroll 1
            for (int s = u; s < 512; s += 128) s5_unit(ap, l, s >> 5, s & 31, lds, tid, lane, wave);
#endif
            xcd_barrier(xsub);
            { KArgs ap3 = kargs(); ssd_norm_rows(ap3, l, u * NWAVES + wave, 128 * NWAVES, lane); }
            { KArgs ap3 = kargs(); unsigned char* ws3 = ap3->ws;
              pg8::Gemm g_{(const pg8::bf16_t*)(ws3 + WS_ZG), (const pg8::bf16_t*)(ws3 + WS_GLU), MTOK, 512, 512}; pg8::StaticOrder S_; S_.init(MTOK, 512, 128, u);
              pg8::EpiGlu EG{(const bf16_t*)(ws3 + WS_ZG), (bf16_t*)(ws3 + WS_YC), ap3->in[31] + l * 512}; pg8::gemm_phase<pg8::EpiGlu, pg8::StaticOrder, true, true>(lds, g_, S_, EG); }
            { KArgs ap2 = kargs(); unsigned char* ws2 = ap2->ws;
              pg8::Gemm g_{(const pg8::bf16_t*)(ws2 + WS_H), (const pg8::bf16_t*)(ws2 + WS_WG + (size_t)2 * 1024 * 1024 * 2), MTOK, 1024, 1024}; pg8::StaticOrder S_; S_.init(MTOK, 1024, 128, u);
              pg8::EpiSigU8 E8{ws2 + WS_GC8}; pg8::gemm_phase<pg8::EpiSigU8, pg8::StaticOrder, true, true>(lds, g_, S_, E8); }
          } }
        xcd_barrier(xbar);
        if (PHM & 4) {
            { FRESH(); pg8::EpiStore ES{(bf16_t*)(ws + WS_TT), 1024}; GEMM_PHASE(pg8::EpiStore, WS_YA, WS_PA, 1024, 512, ES); }
            { FRESH(); pg8::EpiGate<true> EG{(const bf16_t*)(ws + WS_TT), (bf16_t*)(ws + WS_MERGED)}; GEMM_PHASE(pg8::EpiGate<true>, WS_H, WS_WG, 1024, 1024, EG); }
            { FRESH(); pg8::EpiStore ES{(bf16_t*)(ws + WS_TT), 1024}; GEMM_PHASE(pg8::EpiStore, WS_YB, WS_PB, 1024, 512, ES); }
            { FRESH(); pg8::EpiGate<false> EG{(const bf16_t*)(ws + WS_TT), (bf16_t*)(ws + WS_MERGED)}; GEMM_PHASE(pg8::EpiGate<false>, WS_H, WS_WG + (size_t)1024 * 1024 * 2, 1024, 1024, EG); }
            { FRESH(); pg8::EpiMulAccU8 EM{ws + WS_GC8, (bf16_t*)(ws + WS_MERGED)}; GEMM_PHASE(pg8::EpiMulAccU8, WS_YC, WS_PC, 1024, 512, EM); }
        }
        xcd_barrier(xbar);
        if (PHM & 8) { FRESH();
            if (l == 0) { pg8::EpiResid<false> E{(const void*)ap->in[0], (bf16_t*)ap->out}; GEMM_PHASE(pg8::EpiResid<false>, WS_MERGED, WS_WOUT, 1024, 1024, E); }
            else { pg8::EpiResid<true> E{(const void*)ap->out, (bf16_t*)ap->out}; GEMM_PHASE(pg8::EpiResid<true>, WS_MERGED, WS_WOUT, 1024, 1024, E); } }
        xcd_barrier(xbar);
        { FRESH(); rmsnorm_rows<false, true>((const void*)ap->out, ap->in[34] + l * DM, (bf16_t*)(ws + WS_H), nullptr, nullptr, gw, NGW, lane); }
        xcd_barrier(xbar);
        if (PHM & 16) { FRESH(); pg8::EpiSwiglu E{(bf16_t*)(ws + WS_ACT)}; GEMM_PHASE(pg8::EpiSwiglu, WS_H, WS_FIN, 2 * FFH, 1024, E); }
        xcd_barrier(xbar);
        if (PHM & 32) { FRESH(); pg8::EpiResid<true> E{(const void*)ap->out, l == DEPTH - 1 ? (bf16_t*)(ws + WS_XF) : (bf16_t*)ap->out}; GEMM_PHASE(pg8::EpiResid<true>, WS_ACT, WS_FOUT, 1024, FFH, E); }
        xcd_barrier(xbar);
    }
    { KArgs ap = kargs(); final_norm_rows((const bf16_t*)(ap->ws + WS_XF), ap->out, ap->in[37], gw, NGW, lane); }
}

extern "C" void kernel_launch(void* const* d_in, const int* in_sizes, int n_in, void* d_out, int out_size, void* d_ws, size_t ws_size, hipStream_t stream) {
    static int grid = 0;
    if (grid == 0) {
        if (n_in != 38 || out_size != MTOK * DM || ws_size < WS_END) { fprintf(stderr, "kernel_launch: unexpected problem (n_in %d out %d ws %zu, need %zu)\n", n_in, out_size, ws_size, (size_t)WS_END); grid = -1; return; }
        int dev = 0, cus = 0, per_cu = 0;
        (void)hipGetDevice(&dev); (void)hipDeviceGetAttribute(&cus, hipDeviceAttributeMultiprocessorCount, dev);
        if (hipFuncSetAttribute((const void*)hybrid_fwd, hipFuncAttributeMaxDynamicSharedMemorySize, LDS_BYTES) != hipSuccess) { fprintf(stderr, "kernel_launch: hipFuncSetAttribute failed\n"); grid = -1; return; }
        if (hipOccupancyMaxActiveBlocksPerMultiprocessor(&per_cu, (const void*)hybrid_fwd, NTHR, LDS_BYTES) != hipSuccess || per_cu < 1) { fprintf(stderr, "kernel_launch: occupancy query says %d\n", per_cu); per_cu = 1; }
        (void)hipGetLastError();
        grid = cus;
        if (grid != 256) { fprintf(stderr, "kernel_launch: expected 256 CUs, got %d\n", grid); grid = -1; return; }
    }
    if (grid < 0) return;
    Args a{};
    for (int i = 0; i < 38; ++i) a.in[i] = (const float*)d_in[i];
    a.out = (float*)d_out; a.ws = (unsigned char*)d_ws;
    (void)hipMemsetAsync(d_ws, 0, 32768, stream);
    void* args[] = {&a};
    hipError_t e = hipLaunchCooperativeKernel((const void*)hybrid_fwd, dim3(grid), dim3(NTHR), args, LDS_BYTES, stream);
    if (e != hipSuccess) fprintf(stderr, "cooperative launch failed: %s (grid %d)\n", hipGetErrorString(e), grid);
}
```

```cpp
#include <hip/hip_runtime.h>
#include <hip/hip_cooperative_groups.h>
#include <cstdio>
#include <cstdint>
namespace cg = cooperative_groups;

namespace pg8 {
#define PG8_LAS __attribute__((address_space(3)))
typedef unsigned short bf16_t;
typedef short bf16x8 __attribute__((ext_vector_type(8)));
typedef float f32x4 __attribute__((ext_vector_type(4)));
typedef unsigned u32x4 __attribute__((ext_vector_type(4)));
constexpr int BM = 256, BK = 64, HALF = 128, HTB = HALF * BK * 2  , STAGE_BYTES = 8 * HTB, NXCD = 8, WGM = 4;

__host__ __device__ __forceinline__ int lds_byte(int r, int c) { const int st = (r >> 4) * 2 + (c >> 5), rr = r & 15, cc = c & 31, ob = rr * 64 + cc * 2; return st * 1024 + (ob ^ (((ob >> 9) & 1) << 5)); }
__host__ __device__ __forceinline__ void stage_rc(int b, int& R, int& C) { const int st = b / 1024, sb = b % 1024, swz = sb ^ (((sb >> 9) & 1) << 5); R = (st >> 1) * 16 + swz / 64; C = (st & 1) * 32 + (swz % 64) / 2; }
__host__ __device__ __forceinline__ int perm32(int rho) { const int n = rho >> 4, i = rho & 15; return 8 * (i >> 2) + 4 * n + (i & 3); }

struct Unit { int pm, pn; };
struct Gemm { const bf16_t* A; const bf16_t* Bt; int M, N, K; };

struct StaticOrder {
    int nM, nN, nwg, G, c;
    __host__ __device__ void init(int M, int N, int G_, int c_) { nM = M / BM; nN = N / BM; nwg = nM * nN; G = G_; c = c_; }
    __host__ __device__ bool next(int i, Unit& u) const {
        const long L = (long)i * G + c; if (L >= nwg) return false;
        int wgid = (int)L; { const int q = nwg / NXCD, r = nwg % NXCD, xcd = wgid % NXCD, off = wgid / NXCD; wgid = (xcd < r ? xcd * (q + 1) : r * (q + 1) + (xcd - r) * q) + off; }
        const int nig = WGM * nN, gid = wgid / nig, fm = gid * WGM, gsz = (nM - fm) < WGM ? (nM - fm) : WGM;
        u.pm = fm + ((wgid % nig) % gsz); u.pn = (wgid % nig) / gsz; return true;
    }
    __device__ __forceinline__ void a_ready(const Unit&) const {}
    __device__ __forceinline__ void done(const Unit&) const {}
};

template <class Epi, class Sched, bool ALIGN_EPI = false, bool SP2 = false>
__device__ __forceinline__ void gemm_phase(PG8_LAS unsigned char* lds, const Gemm g, const Sched& S, const Epi& E) {
    int tid_ = threadIdx.x; asm volatile("" : "+v"(tid_));
    const int tid = tid_, wid = __builtin_amdgcn_readfirstlane(tid >> 6), lane = tid & 63, wr = wid >> 2, wc = wid & 3, fr = lane & 15, fq = lane >> 4;
    const int K = g.K, nt = K / BK;
    unsigned voffA[2], voffB[2];
#pragma unroll
    for (int i = 0; i < 2; ++i) { int R, C; stage_rc(tid * 16 + i * 8192, R, C); const int Rb = Epi::PERM ? ((R & ~31) + perm32(R & 31)) : R;
        voffA[i] = (unsigned)(R * K + C) * 2u; voffB[i] = (unsigned)(Rb * K + C) * 2u; }
    const size_t kstep = (size_t)(BK * 2);
    const size_t hstep = (size_t)HALF * K * 2;
    const size_t tstep = 2 * hstep;
    const unsigned ldsw = (unsigned)wid * 1024u;
    const int aoff = lds_byte(wr * 64 + fr, fq * 8), boff = lds_byte(wc * 32 + fr, fq * 8);
#define PG8_SA(b, h) (((b) * 2 + (h)) * HTB)
#define PG8_SB(b, h) ((4 + (b) * 2 + (h)) * HTB)
#define PG8_STAGE(bufoff, gbase, voff) do { _Pragma("unroll") for (int _i = 0; _i < 2; ++_i) \
        __builtin_amdgcn_global_load_lds((const unsigned*)((const char*)(gbase) + (voff)[_i]), (PG8_LAS unsigned*)(lds + (bufoff) + ldsw + _i * 8192), 16, 0, 0); } while (0)
#define PG8_LDA(dst, b, h) do { _Pragma("unroll") for (int m = 0; m < 4; ++m) _Pragma("unroll") for (int k = 0; k < 2; ++k) dst[m][k] = *(const PG8_LAS bf16x8*)(lds + PG8_SA(b, h) + aoff + m * 2048 + k * 1024); } while (0)
#define PG8_LDB(dst, b, h) do { _Pragma("unroll") for (int n = 0; n < 2; ++n) _Pragma("unroll") for (int k = 0; k < 2; ++k) dst[n][k] = *(const PG8_LAS bf16x8*)(lds + PG8_SB(b, h) + boff + n * 2048 + k * 1024); } while (0)
#define PG8_MMA(ai, bj, At, Bt) do { __builtin_amdgcn_s_setprio(1); _Pragma("unroll") for (int m = 0; m < 4; ++m) _Pragma("unroll") for (int n = 0; n < 2; ++n) _Pragma("unroll") for (int k = 0; k < 2; ++k) \
        acc[ai][bj][m][n] = __builtin_amdgcn_mfma_f32_16x16x32_bf16(Bt[n][k], At[m][k], acc[ai][bj][m][n], 0, 0, 0); __builtin_amdgcn_s_setprio(0); } while (0)
#define PG8_WAIT_V(n) asm volatile("s_waitcnt vmcnt(" #n ")" ::: "memory")
#define PG8_WAIT_L(n) asm volatile("s_waitcnt lgkmcnt(" #n ")" ::: "memory")
#define PG8_BAR __builtin_amdgcn_s_barrier()
#define PG8_SCHED __builtin_amdgcn_sched_barrier(0)
    Unit cur, nxt; int ui = 0;
    if (!S.next(0, cur)) return;
    f32x4 acc[2][2][4][2];
#pragma unroll
    for (int a = 0; a < 2; ++a)
#pragma unroll
        for (int b = 0; b < 2; ++b)
#pragma unroll
            for (int m = 0; m < 4; ++m)
#pragma unroll
                for (int n = 0; n < 2; ++n) acc[a][b][m][n] = (f32x4){0.f, 0.f, 0.f, 0.f};
    bf16x8 At[4][2], B0[2][2], B1[2][2];
    const char* cA = (const char*)g.A + (size_t)cur.pm * tstep; const char* cB = (const char*)g.Bt + (size_t)cur.pn * tstep;
    S.a_ready(cur);
    if constexpr (SP2) {
        PG8_STAGE(PG8_SB(0, 0), cB, voffB); PG8_STAGE(PG8_SB(0, 1), cB + hstep, voffB); PG8_STAGE(PG8_SA(0, 0), cA, voffA); PG8_STAGE(PG8_SA(0, 1), cA + hstep, voffA);
        if (wr == 1) PG8_BAR;
        PG8_WAIT_V(2); PG8_BAR;
        PG8_STAGE(PG8_SB(1, 0), cB + kstep, voffB); PG8_STAGE(PG8_SA(1, 0), cA + kstep, voffA); PG8_STAGE(PG8_SB(1, 1), cB + hstep + kstep, voffB);
        PG8_WAIT_V(6); PG8_BAR;
    } else {
        PG8_STAGE(PG8_SB(0, 0), cB, voffB); PG8_STAGE(PG8_SA(0, 0), cA, voffA); PG8_STAGE(PG8_SB(0, 1), cB + hstep, voffB); PG8_STAGE(PG8_SA(0, 1), cA + hstep, voffA);
        if (wr == 1) PG8_BAR;
        PG8_WAIT_V(4); PG8_BAR;
        PG8_STAGE(PG8_SB(1, 0), cB + kstep, voffB); PG8_STAGE(PG8_SA(1, 0), cA + kstep, voffA); PG8_STAGE(PG8_SB(1, 1), cB + hstep + kstep, voffB);
        PG8_WAIT_V(6); PG8_BAR;
    }
    for (;;) {
        const bool has_next = S.next(ui + 1, nxt);
        const char* nA = has_next ? (const char*)g.A + (size_t)nxt.pm * tstep : cA; const char* nB = has_next ? (const char*)g.Bt + (size_t)nxt.pn * tstep : cB;
        for (int t = 0; t < nt; t += 2) {
            const bool last = (t == nt - 2);
            const char* a1 = cA + (size_t)(t + 1) * kstep;
            const char* a2 = last ? nA : cA + (size_t)(t + 2) * kstep; const char* b2 = last ? nB : cB + (size_t)(t + 2) * kstep;
            const char* a3 = a2 + kstep; const char* b3 = b2 + kstep;
            if (last && has_next) S.a_ready(nxt);
            if constexpr (SP2) {
            PG8_LDB(B0, 0, 0); PG8_LDB(B1, 0, 1); PG8_SCHED; PG8_LDA(At, 0, 0); PG8_STAGE(PG8_SA(1, 1), a1 + hstep, voffA);
            PG8_WAIT_V(8); PG8_WAIT_L(0); PG8_BAR; PG8_MMA(0, 0, At, B0); PG8_MMA(0, 1, At, B1); PG8_BAR; PG8_SCHED;
            PG8_LDA(At, 0, 1); PG8_STAGE(PG8_SB(0, 0), b2, voffB); PG8_STAGE(PG8_SB(0, 1), b2 + hstep, voffB); PG8_STAGE(PG8_SA(0, 0), a2, voffA);
            PG8_WAIT_V(8); PG8_WAIT_L(0); PG8_BAR; PG8_MMA(1, 0, At, B0); PG8_MMA(1, 1, At, B1); PG8_BAR; PG8_SCHED;
            PG8_LDB(B0, 1, 0); PG8_LDB(B1, 1, 1); PG8_SCHED; PG8_LDA(At, 1, 0); PG8_STAGE(PG8_SA(0, 1), a2 + hstep, voffA);
            PG8_WAIT_V(8); PG8_WAIT_L(0); PG8_BAR; PG8_MMA(0, 0, At, B0); PG8_MMA(0, 1, At, B1); PG8_BAR; PG8_SCHED;
            PG8_LDA(At, 1, 1); PG8_STAGE(PG8_SB(1, 0), b3, voffB); PG8_STAGE(PG8_SB(1, 1), b3 + hstep, voffB); PG8_STAGE(PG8_SA(1, 0), a3, voffA);
            PG8_WAIT_V(8); PG8_WAIT_L(0); PG8_BAR; PG8_MMA(1, 0, At, B0); PG8_MMA(1, 1, At, B1); PG8_BAR; PG8_SCHED;
            } else {
            PG8_LDB(B0, 0, 0); PG8_SCHED; PG8_LDA(At, 0, 0); PG8_STAGE(PG8_SA(1, 1), a1 + hstep, voffA);
            PG8_WAIT_L(8); PG8_BAR; PG8_WAIT_L(0); PG8_MMA(0, 0, At, B0); PG8_BAR; PG8_SCHED;
            PG8_LDB(B1, 0, 1); PG8_STAGE(PG8_SB(0, 0), b2, voffB);
            PG8_BAR; PG8_WAIT_L(0); PG8_MMA(0, 1, At, B1); PG8_BAR;
            PG8_LDA(At, 0, 1); PG8_STAGE(PG8_SA(0, 0), a2, voffA);
            PG8_BAR; PG8_WAIT_L(0); PG8_MMA(1, 0, At, B0); PG8_BAR; PG8_SCHED;
            PG8_STAGE(PG8_SB(0, 1), b2 + hstep, voffB);
            PG8_WAIT_V(6); PG8_BAR; PG8_MMA(1, 1, At, B1); PG8_BAR;
            PG8_LDB(B0, 1, 0); PG8_SCHED; PG8_LDA(At, 1, 0); PG8_STAGE(PG8_SA(0, 1), a2 + hstep, voffA);
            PG8_WAIT_L(8); PG8_BAR; PG8_WAIT_L(0); PG8_MMA(0, 0, At, B0); PG8_BAR; PG8_SCHED;
            PG8_LDB(B1, 1, 1); PG8_STAGE(PG8_SB(1, 0), b3, voffB);
            PG8_BAR; PG8_WAIT_L(0); PG8_MMA(0, 1, At, B1); PG8_BAR;
            PG8_LDA(At, 1, 1); PG8_STAGE(PG8_SA(1, 0), a3, voffA);
            PG8_BAR; PG8_WAIT_L(0); PG8_MMA(1, 0, At, B0); PG8_BAR; PG8_SCHED;
            PG8_STAGE(PG8_SB(1, 1), b3 + hstep, voffB);
            PG8_WAIT_V(6); PG8_BAR; PG8_MMA(1, 1, At, B1); PG8_BAR;
            }
        }
        if constexpr (ALIGN_EPI) { if (wr == 0) PG8_BAR; }
        if constexpr (!Epi::AFTER_DRAIN) { E(acc, cur, wr, wc, fr, fq); S.done(cur); }
        if (!has_next) break;
#pragma unroll
        for (int a = 0; a < 2; ++a)
#pragma unroll
            for (int b = 0; b < 2; ++b)
#pragma unroll
                for (int m = 0; m < 4; ++m)
#pragma unroll
                    for (int n = 0; n < 2; ++n) acc[a][b][m][n] = (f32x4){0.f, 0.f, 0.f, 0.f};
        cur = nxt; cA = nA; cB = nB; ++ui;
        if constexpr (ALIGN_EPI) { if (wr == 1) PG8_BAR; }
    }
    PG8_WAIT_V(0);
    if constexpr (!ALIGN_EPI) { if (wr == 0) PG8_BAR; }
    PG8_BAR;
    if constexpr (Epi::AFTER_DRAIN) { E.fused(acc, cur, wr, wc, fr, fq, lds, wid, lane); S.done(cur); }
#undef PG8_SA
#undef PG8_SB
#undef PG8_STAGE
#undef PG8_LDA
#undef PG8_LDB
#undef PG8_MMA
#undef PG8_WAIT_V
#undef PG8_WAIT_L
#undef PG8_BAR
#undef PG8_SCHED
}
}

#ifndef PG8_SP2
#define PG8_SP2 true
#endif
#ifndef PG8_ALIGN
#define PG8_ALIGN true
#endif

#define LAS __attribute__((address_space(3)))
typedef unsigned short bf16_t;
typedef short bf16x8 __attribute__((ext_vector_type(8)));
typedef float f32x4 __attribute__((ext_vector_type(4)));
typedef float f32x2 __attribute__((ext_vector_type(2)));
typedef unsigned u32x4 __attribute__((ext_vector_type(4)));
typedef unsigned u32x2 __attribute__((ext_vector_type(2)));

__device__ __forceinline__ unsigned f2bf(float f) { unsigned u = __builtin_bit_cast(unsigned, f); return (u + 0x7fffu + ((u >> 16) & 1u)) >> 16; }
__device__ __forceinline__ unsigned pk2(float lo, float hi) { unsigned r; asm volatile("v_cvt_pk_bf16_f32 %0, %1, %2" : "=v"(r) : "v"(lo), "v"(hi)); return r; }
__device__ __forceinline__ float bf_lo(unsigned w) { return __builtin_bit_cast(float, w << 16); }
__device__ __forceinline__ float bf_hi(unsigned w) { return __builtin_bit_cast(float, w & 0xffff0000u); }
__device__ __forceinline__ float bf2f(bf16_t b) { return __builtin_bit_cast(float, (unsigned)b << 16); }
__device__ __forceinline__ void unpack8(u32x4 v, float* o) { o[0] = bf_lo(v.x); o[1] = bf_hi(v.x); o[2] = bf_lo(v.y); o[3] = bf_hi(v.y); o[4] = bf_lo(v.z); o[5] = bf_hi(v.z); o[6] = bf_lo(v.w); o[7] = bf_hi(v.w); }
__device__ __forceinline__ u32x4 pack8(const float* o) { u32x4 v; v.x = pk2(o[0], o[1]); v.y = pk2(o[2], o[3]); v.z = pk2(o[4], o[5]); v.w = pk2(o[6], o[7]); return v; }
__device__ __forceinline__ float sigm(float x) { return __builtin_amdgcn_rcpf(1.f + __expf(-x)); }
__device__ __forceinline__ float ftanh(float x) { return 1.f - 2.f * __builtin_amdgcn_rcpf(1.f + __expf(2.f * x)); }
__device__ __forceinline__ float softplusf(float z) { return z > 20.f ? z : log1pf(expf(z)); }
template <int CTRL> __device__ __forceinline__ float dppf(float x) { return __builtin_bit_cast(float, __builtin_amdgcn_update_dpp(0, __builtin_bit_cast(int, x), CTRL, 0xf, 0xf, true)); }
__device__ __forceinline__ float red8(float x) { x += dppf<0xB1>(x); x += dppf<0x4E>(x); x += dppf<0x141>(x); return x; }
__device__ __forceinline__ float red16(float x) { x = red8(x); x += dppf<0x140>(x); return x; }
__device__ __forceinline__ float red32(float x) { x = red16(x); x += __shfl_xor(x, 16); return x; }
__device__ __forceinline__ float wave_sum(float x) { x = red32(x); x += __shfl_xor(x, 32); return x; }
__device__ __forceinline__ bf16x8 ldsfrag(const LAS bf16_t* base, int row, int stride, int k) { return *(const LAS bf16x8*)(base + row * stride + k); }
#define MFMA16(a, b, c) __builtin_amdgcn_mfma_f32_16x16x32_bf16((a), (b), (c), 0, 0, 0)

namespace pg8 {
struct EpiStore {
    static constexpr bool PERM = true, AFTER_DRAIN = false;
    bf16_t* O; int ldc;
    __device__ __forceinline__ void operator()(const f32x4 (&acc)[2][2][4][2], const Unit& u, int wr, int wc, int fr, int fq) const {
        const int row0 = u.pm * BM + wr * 64 + fr, col0 = u.pn * BM + wc * 32 + 8 * fq;
#pragma unroll
        for (int ai = 0; ai < 2; ++ai)
#pragma unroll
            for (int m = 0; m < 4; ++m) { bf16_t* rowp = O + (size_t)(row0 + ai * HALF + m * 16) * ldc + col0;
#pragma unroll
                for (int bj = 0; bj < 2; ++bj) { const f32x4 v0 = acc[ai][bj][m][0], v1 = acc[ai][bj][m][1];
                    u32x4 w; w.x = pk2(v0[0], v0[1]); w.y = pk2(v0[2], v0[3]); w.z = pk2(v1[0], v1[1]); w.w = pk2(v1[2], v1[3]);
                    *(u32x4*)(rowp + bj * HALF) = w; } }
    }
};
template <bool FIRST> struct EpiGate {
    static constexpr bool PERM = true, AFTER_DRAIN = false;
    const bf16_t* T; bf16_t* Mg;
    __device__ __forceinline__ void operator()(const f32x4 (&acc)[2][2][4][2], const Unit& u, int wr, int wc, int fr, int fq) const {
        const int row0 = u.pm * BM + wr * 64 + fr, col0 = u.pn * BM + wc * 32 + 8 * fq;
#pragma unroll
        for (int ai = 0; ai < 2; ++ai) {
            u32x4 tb[4][2], pb[4][2];
#pragma unroll
            for (int m = 0; m < 4; ++m)
#pragma unroll
                for (int bj = 0; bj < 2; ++bj) { const size_t ro = (size_t)(row0 + ai * HALF + m * 16) * 1024 + col0 + bj * HALF;
                    tb[m][bj] = *(const u32x4*)(T + ro); if (!FIRST) pb[m][bj] = *(const u32x4*)(Mg + ro); }
            asm volatile("" ::: "memory");
#pragma unroll
            for (int m = 0; m < 4; ++m)
#pragma unroll
                for (int bj = 0; bj < 2; ++bj) { const size_t ro = (size_t)(row0 + ai * HALF + m * 16) * 1024 + col0 + bj * HALF;
                    const f32x4 v0 = acc[ai][bj][m][0], v1 = acc[ai][bj][m][1];
                    float t[8], r[8]; unpack8(tb[m][bj], t);
                    r[0] = sigm(v0[0]) * t[0]; r[1] = sigm(v0[1]) * t[1]; r[2] = sigm(v0[2]) * t[2]; r[3] = sigm(v0[3]) * t[3];
                    r[4] = sigm(v1[0]) * t[4]; r[5] = sigm(v1[1]) * t[5]; r[6] = sigm(v1[2]) * t[6]; r[7] = sigm(v1[3]) * t[7];
                    if (!FIRST) { float p[8]; unpack8(pb[m][bj], p);
#pragma unroll
                        for (int e = 0; e < 8; ++e) r[e] += p[e]; }
                    *(u32x4*)(Mg + ro) = pack8(r); }
        }
    }
};
template <bool BASE_BF> struct EpiResid {
    static constexpr bool PERM = true, AFTER_DRAIN = false;
    const void* base; bf16_t* out;
    __device__ __forceinline__ void operator()(const f32x4 (&acc)[2][2][4][2], const Unit& u, int wr, int wc, int fr, int fq) const {
        const int row0 = u.pm * BM + wr * 64 + fr, col0 = u.pn * BM + wc * 32 + 8 * fq;
#pragma unroll
        for (int ai = 0; ai < 2; ++ai) {
            f32x4 bb[4][2][2]; u32x4 bh[4][2];
#pragma unroll
            for (int m = 0; m < 4; ++m)
#pragma unroll
                for (int bj = 0; bj < 2; ++bj) { const size_t ro = (size_t)(row0 + ai * HALF + m * 16) * 1024 + col0 + bj * HALF;
                    if (BASE_BF) bh[m][bj] = *(const u32x4*)((const bf16_t*)base + ro);
                    else { bb[m][bj][0] = *(const f32x4*)((const float*)base + ro); bb[m][bj][1] = *(const f32x4*)((const float*)base + ro + 4); } }
            asm volatile("" ::: "memory");
#pragma unroll
            for (int m = 0; m < 4; ++m)
#pragma unroll
                for (int bj = 0; bj < 2; ++bj) { const size_t ro = (size_t)(row0 + ai * HALF + m * 16) * 1024 + col0 + bj * HALF;
                    float b[8];
                    if (BASE_BF) unpack8(bh[m][bj], b);
                    else { b[0] = bb[m][bj][0].x; b[1] = bb[m][bj][0].y; b[2] = bb[m][bj][0].z; b[3] = bb[m][bj][0].w; b[4] = bb[m][bj][1].x; b[5] = bb[m][bj][1].y; b[6] = bb[m][bj][1].z; b[7] = bb[m][bj][1].w; }
                    const f32x4 v0 = acc[ai][bj][m][0], v1 = acc[ai][bj][m][1];
                    b[0] += v0[0]; b[1] += v0[1]; b[2] += v0[2]; b[3] += v0[3]; b[4] += v1[0]; b[5] += v1[1]; b[6] += v1[2]; b[7] += v1[3];
                    *(u32x4*)(out + ro) = pack8(b); }
        }
    }
};
struct EpiSwiglu {
    static constexpr bool PERM = true, AFTER_DRAIN = false;
    bf16_t* O;
    __device__ __forceinline__ void operator()(const f32x4 (&acc)[2][2][4][2], const Unit& u, int wr, int wc, int fr, int fq) const {
        const int row0 = u.pm * BM + wr * 64 + fr, col0 = u.pn * HALF + wc * 32 + 8 * fq;
#pragma unroll
        for (int ai = 0; ai < 2; ++ai)
#pragma unroll
            for (int m = 0; m < 4; ++m) { bf16_t* p = O + (size_t)(row0 + ai * HALF + m * 16) * 2816 + col0;
                float r[8];
#pragma unroll
                for (int n = 0; n < 2; ++n)
#pragma unroll
                    for (int e = 0; e < 4; ++e) { const float g = acc[ai][0][m][n][e], up = acc[ai][1][m][n][e]; r[4 * n + e] = g * sigm(g) * up; }
                *(u32x4*)p = pack8(r); }
    }
};
struct EpiSigU8 {
    static constexpr bool PERM = true, AFTER_DRAIN = false;
    unsigned char* O;
    __device__ __forceinline__ void operator()(const f32x4 (&acc)[2][2][4][2], const Unit& u, int wr, int wc, int fr, int fq) const {
        const int row0 = u.pm * BM + wr * 64 + fr, col0 = u.pn * BM + wc * 32 + 8 * fq;
#pragma unroll
        for (int ai = 0; ai < 2; ++ai)
#pragma unroll
            for (int m = 0; m < 4; ++m)
#pragma unroll
                for (int bj = 0; bj < 2; ++bj) { const f32x4 v0 = acc[ai][bj][m][0], v1 = acc[ai][bj][m][1];
                    unsigned q[8];
#pragma unroll
                    for (int e = 0; e < 4; ++e) { q[e] = (unsigned)(sigm(v0[e]) * 255.f + 0.5f); q[4 + e] = (unsigned)(sigm(v1[e]) * 255.f + 0.5f); }
                    u32x2 w; w.x = q[0] | (q[1] << 8) | (q[2] << 16) | (q[3] << 24); w.y = q[4] | (q[5] << 8) | (q[6] << 16) | (q[7] << 24);
                    *(u32x2*)(O + (size_t)(row0 + ai * HALF + m * 16) * 1024 + col0 + bj * HALF) = w; }
    }
};
struct EpiMulAccU8 {
    static constexpr bool PERM = true, AFTER_DRAIN = false;
    const unsigned char* G; bf16_t* Mg;
    __device__ __forceinline__ void operator()(const f32x4 (&acc)[2][2][4][2], const Unit& u, int wr, int wc, int fr, int fq) const {
        const int row0 = u.pm * BM + wr * 64 + fr, col0 = u.pn * BM + wc * 32 + 8 * fq;
#pragma unroll
        for (int ai = 0; ai < 2; ++ai) {
            u32x2 gb[4][2]; u32x4 pb[4][2];
#pragma unroll
            for (int m = 0; m < 4; ++m)
#pragma unroll
                for (int bj = 0; bj < 2; ++bj) { const size_t ro = (size_t)(row0 + ai * HALF + m * 16) * 1024 + col0 + bj * HALF;
                    gb[m][bj] = *(const u32x2*)(G + ro); pb[m][bj] = *(const u32x4*)(Mg + ro); }
            asm volatile("" ::: "memory");
#pragma unroll
            for (int m = 0; m < 4; ++m)
#pragma unroll
                for (int bj = 0; bj < 2; ++bj) { const size_t ro = (size_t)(row0 + ai * HALF + m * 16) * 1024 + col0 + bj * HALF;
                    const f32x4 v0 = acc[ai][bj][m][0], v1 = acc[ai][bj][m][1];
                    float p[8], r[8]; unpack8(pb[m][bj], p);
                    const unsigned ga = gb[m][bj].x, gc = gb[m][bj].y; const float k = 1.f / 255.f;
                    r[0] = p[0] + (float)(ga & 255u) * k * v0[0]; r[1] = p[1] + (float)((ga >> 8) & 255u) * k * v0[1]; r[2] = p[2] + (float)((ga >> 16) & 255u) * k * v0[2]; r[3] = p[3] + (float)(ga >> 24) * k * v0[3];
                    r[4] = p[4] + (float)(gc & 255u) * k * v1[0]; r[5] = p[5] + (float)((gc >> 8) & 255u) * k * v1[1]; r[6] = p[6] + (float)((gc >> 16) & 255u) * k * v1[2]; r[7] = p[7] + (float)(gc >> 24) * k * v1[3];
                    *(u32x4*)(Mg + ro) = pack8(r); }
        }
    }
};
struct EpiGlu {
    static constexpr bool PERM = true, AFTER_DRAIN = false;
    const bf16_t* Z; bf16_t* O; const float* bias;
    __device__ __forceinline__ void operator()(const f32x4 (&acc)[2][2][4][2], const Unit& u, int wr, int wc, int fr, int fq) const {
        const int row0 = u.pm * BM + wr * 64 + fr, col0 = u.pn * BM + wc * 32 + 8 * fq;
        f32x4 bv[2][2];
#pragma unroll
        for (int bj = 0; bj < 2; ++bj) { bv[bj][0] = *(const f32x4*)(bias + col0 + bj * HALF); bv[bj][1] = *(const f32x4*)(bias + col0 + bj * HALF + 4); }
#pragma unroll
        for (int ai = 0; ai < 2; ++ai) {
            u32x4 zb[4][2];
#pragma unroll
            for (int m = 0; m < 4; ++m)
#pragma unroll
                for (int bj = 0; bj < 2; ++bj) zb[m][bj] = *(const u32x4*)(Z + (size_t)(row0 + ai * HALF + m * 16) * 512 + col0 + bj * HALF);
            asm volatile("" ::: "memory");
#pragma unroll
            for (int m = 0; m < 4; ++m)
#pragma unroll
                for (int bj = 0; bj < 2; ++bj) { const f32x4 v0 = acc[ai][bj][m][0], v1 = acc[ai][bj][m][1];
                    float z[8], r[8]; unpack8(zb[m][bj], z);
#pragma unroll
                    for (int e = 0; e < 4; ++e) { r[e] = z[e] * sigm(v0[e] + bv[bj][0][e]); r[4 + e] = z[4 + e] * sigm(v1[e] + bv[bj][1][e]); }
                    *(u32x4*)(O + (size_t)(row0 + ai * HALF + m * 16) * 512 + col0 + bj * HALF) = pack8(r); }
        }
    }
};
}

constexpr int DM = 1024, BATCH = 16, SEQ = 2048, MTOK = BATCH * SEQ, DEPTH = 2;
constexpr int IN_COLS = 6920, NPROJ = 3840, FFH = 2816;
constexpr int P_R = 0, P_K = 512, P_V = 1024, P_WD = 1536, P_AD = 1600, P_GD = 1664, P_Z = 1792, P_XS = 2304, P_B = 2816, P_C = 3072, P_U = 3328;
constexpr int NWAVES = 8, NTHR = 512;
constexpr size_t MiB = 1u << 20, KiB = 1u << 10;
constexpr size_t WS_WIN = 1 * MiB, WS_WG = 9 * MiB, WS_PA = 15 * MiB, WS_PB = 16 * MiB, WS_PC = 17 * MiB, WS_GLU = 18 * MiB, WS_WOUT = 19 * MiB,
                 WS_FIN = 21 * MiB, WS_FOUT = 32 * MiB, WS_WUP = 38 * MiB, WS_AUP = 38 * MiB + 64 * KiB, WS_GUP = 38 * MiB + 128 * KiB, WS_A16 = 38 * MiB + 256 * KiB,
                 WS_TM = 39 * MiB, WS_M3 = 45 * MiB, WS_DT = 47 * MiB, WS_H = 48 * MiB, WS_YA = 112 * MiB, WS_YB = 144 * MiB, WS_YC = 176 * MiB, WS_ZG = 208 * MiB,
                 WS_PROJ = 240 * MiB, WS_GC8 = 480 * MiB  , WS_END = 512 * MiB;
constexpr size_t WS_XF = 416 * MiB;
constexpr size_t WS_MERGED = WS_PROJ, WS_TT = WS_PROJ + 64 * MiB, WS_ACT = WS_PROJ;
constexpr int LDS_BYTES = 151552;

struct Args { const float* in[38]; float* out; unsigned char* ws; };
typedef const __attribute__((address_space(4))) Args* KArgs;
typedef const __attribute__((address_space(4))) Args& KArgsRef;
__device__ __forceinline__ KArgs kargs() { KArgs p = (KArgs)__builtin_amdgcn_kernarg_segment_ptr(); asm volatile("" : "+s"(p)); return p; }
__device__ __forceinline__ int opq(int x) { asm volatile("" : "+v"(x)); return x; }

__device__ __forceinline__ void tr_item(const float* __restrict__ W, int ldw, int k0, int c0, bf16_t* __restrict__ WT, int K, int n0, LAS float* scr, int lane) {
    float wv_[32];
#pragma unroll
    for (int i = 0; i < 32; ++i) { const int kk = 2 * i + (lane >> 5); wv_[i] = W[(size_t)(k0 + kk) * ldw + c0 + (lane & 31)]; }
#pragma unroll
    for (int i = 0; i < 32; ++i) { const int kk = 2 * i + (lane >> 5); scr[kk * 33 + (lane & 31)] = wv_[i]; }
    asm volatile("s_waitcnt lgkmcnt(0)" ::: "memory");
    const int c = lane & 7;
#pragma unroll
    for (int j = 0; j < 4; ++j) { const int n = (lane >> 3) + 8 * j; const LAS float* s = scr + (8 * c) * 33 + n;
        u32x4 o; o.x = pk2(s[0 * 33], s[1 * 33]); o.y = pk2(s[2 * 33], s[3 * 33]); o.z = pk2(s[4 * 33], s[5 * 33]); o.w = pk2(s[6 * 33], s[7 * 33]);
        *(u32x4*)(WT + (size_t)(n0 + n) * K + k0 + 8 * c) = o; }
    asm volatile("s_waitcnt lgkmcnt(0)" ::: "memory");
}

__device__ __forceinline__ void s5_prep(KArgs ap_, int l, int g, int q, LAS unsigned char* lds, int tid) {
    KArgs ap = ap_; asm volatile("" : "+s"(ap)); KArgsRef a = *ap; tid = opq(tid);
    LAS float* AR = (LAS float*)lds;
    LAS float* AI = AR + 17 * 64;
    LAS float* BBR = AI + 17 * 64;
    LAS float* BBI = BBR + 1024;
    LAS float* CR = BBI + 1024;
    LAS float* CI = CR + 1024;
    LAS float* KT = CI + 1024;
    unsigned char* ws = a.ws;
    bf16_t* TM = (bf16_t*)(ws + WS_TM) + (size_t)g * 384 * 256;
    bf16_t* M3 = (bf16_t*)(ws + WS_M3) + (size_t)g * 256 * 128;
    float* A16 = (float*)(ws + WS_A16) + g * 128;
    const float* dsk = a.in[29] + l * 512 + 16 * g;
    const float step = expf(a.in[24][l * 32 + g]);
    const float* lre = a.in[22] + (size_t)(l * 32 + g) * 64; const float* lim = a.in[23] + (size_t)(l * 32 + g) * 64;
    for (int e = tid; e < 17 * 64; e += NTHR) { const int t = e >> 6, n = e & 63; const float lr = lre[n], li = lim[n];
        const float mag = expf(lr * step * (float)t), ang = li * step * (float)t; AR[e] = mag * cosf(ang); AI[e] = mag * sinf(ang); }
    for (int e = tid; e < 1024; e += NTHR) { CR[e] = a.in[27][(size_t)(l * 32 + g) * 1024 + e]; CI[e] = a.in[28][(size_t)(l * 32 + g) * 1024 + e]; }
    __syncthreads();
    for (int e = tid; e < 1024; e += NTHR) { const int n = e >> 4, i = e & 15; const float lr = lre[n], li = lim[n];
        const float abr = AR[64 + n], abi = AI[64 + n], den = lr * lr + li * li;
        const float cre = ((abr - 1.f) * lr + abi * li) / den, cim = (abi * lr - (abr - 1.f) * li) / den;
        const float br = a.in[25][((size_t)(l * 32 + g) * 64 + n) * 16 + i], bi = a.in[26][((size_t)(l * 32 + g) * 64 + n) * 16 + i];
        BBR[e] = cre * br - cim * bi; BBI[e] = cre * bi + cim * br; }
    if (q == 0 && tid < 64) { A16[2 * tid] = AR[16 * 64 + tid]; A16[2 * tid + 1] = AI[16 * 64 + tid]; }
    __syncthreads();
    for (int e2 = tid; e2 < 1024; e2 += NTHR) { const int e = 1024 * q + e2; const int t = e >> 8, o = (e >> 4) & 15, i = e & 15; float s = 0.f;
        for (int n = 0; n < 64; ++n) { const float cr = CR[o * 64 + n], ci = CI[o * 64 + n], pr = AR[t * 64 + n], pi = AI[t * 64 + n];
            const float xr = cr * pr - ci * pi, xi = cr * pi + ci * pr; s += xr * BBR[n * 16 + i] - xi * BBI[n * 16 + i]; }
        if (t == 0 && o == i) s += dsk[o];
        KT[e] = s; }
    __syncthreads();
    for (int e = tid; e < 256 * 128; e += NTHR) { const int nn = e >> 7, kk = 2 * (e & 127), t = nn >> 4, o = nn & 15, j = kk >> 4, i = kk & 15, d = t - j;
        if (d >= 0 ? (d >> 2) == q : q == 0) { float v0 = 0.f, v1 = 0.f; if (d >= 0) { v0 = KT[(d * 16 + o) * 16 + i]; v1 = KT[(d * 16 + o) * 16 + i + 1]; }
            *(unsigned*)(TM + (size_t)nn * 256 + kk) = pk2(v0, v1); } }
    for (int e = tid; e < 32 * 128; e += NTHR) { const int rr = 32 * q + (e >> 7), kk = 2 * (e & 127), n = rr >> 1, ri = rr & 1, j = kk >> 4, i = kk & 15;
        const float pr = AR[(15 - j) * 64 + n], pi = AI[(15 - j) * 64 + n];
        float v[2];
#pragma unroll
        for (int qq = 0; qq < 2; ++qq) { const float br = BBR[n * 16 + i + qq], bi = BBI[n * 16 + i + qq]; v[qq] = ri == 0 ? pr * br - pi * bi : pr * bi + pi * br; }
        *(unsigned*)(TM + (size_t)(256 + rr) * 256 + kk) = pk2(v[0], v[1]); }
    for (int e = tid; e < 64 * 64; e += NTHR) { const int nn = 64 * q + (e >> 6), n = e & 63, t = nn >> 4, o = nn & 15;
        const float cr = CR[o * 64 + n], ci = CI[o * 64 + n], pr = AR[(t + 1) * 64 + n], pi = AI[(t + 1) * 64 + n];
        *(unsigned*)(M3 + (size_t)nn * 128 + 2 * n) = pk2(cr * pr - ci * pi, -(cr * pi + ci * pr)); }
    __syncthreads();
}

template <bool WITH_DT, bool IN_BF> __device__ __forceinline__ void rmsnorm_rows(const void* X, const float* gamma, bf16_t* H, float* DT, const LAS float* wdt, int gw, int NGW, int lane) {
    lane = opq(lane);
    f32x4 g[4];
#pragma unroll
    for (int j = 0; j < 4; ++j) g[j] = *(const f32x4*)(gamma + 4 * lane + 256 * j);
    for (int m = gw; m < MTOK; m += 4 * NGW) {
        f32x4 v[4][4]; float s[4];
#pragma unroll
        for (int r = 0; r < 4; ++r) { const size_t xo = (size_t)(m + r * NGW) * DM + 4 * lane; s[r] = 0.f;
#pragma unroll
            for (int j = 0; j < 4; ++j) {
                if (IN_BF) { const u32x2 w = *(const u32x2*)((const bf16_t*)X + xo + 256 * j); v[r][j] = (f32x4){bf_lo(w.x), bf_hi(w.x), bf_lo(w.y), bf_hi(w.y)}; }
                else v[r][j] = *(const f32x4*)((const float*)X + xo + 256 * j);
                s[r] += (v[r][j].x * v[r][j].x + v[r][j].y * v[r][j].y) + (v[r][j].z * v[r][j].z + v[r][j].w * v[r][j].w); } }
#pragma unroll
        for (int r = 0; r < 4; ++r) {
            const float rinv = 1.f / sqrtf(wave_sum(s[r]) * (1.f / DM) + 1e-6f);
            bf16_t* hr = H + (size_t)(m + r * NGW) * DM + 4 * lane;
#pragma unroll
            for (int j = 0; j < 4; ++j) { v[r][j] = v[r][j] * rinv * g[j]; u32x2 o; o.x = pk2(v[r][j].x, v[r][j].y); o.y = pk2(v[r][j].z, v[r][j].w); *(u32x2*)(hr + 256 * j) = o; }
            if (WITH_DT) {
                float d[8];
#pragma unroll
                for (int q = 0; q < 8; ++q) { d[q] = 0.f;
#pragma unroll
                    for (int j = 0; j < 4; ++j) { const f32x4 w = *(const LAS f32x4*)(wdt + q * 1024 + 4 * lane + 256 * j); d[q] += (v[r][j].x * w.x + v[r][j].y * w.y) + (v[r][j].z * w.z + v[r][j].w * w.w); } }
#pragma unroll
                for (int q = 0; q < 8; ++q) d[q] = wave_sum(d[q]);
                if (lane == 0) { *(f32x4*)(DT + (size_t)(m + r * NGW) * 8) = (f32x4){d[0], d[1], d[2], d[3]}; *(f32x4*)(DT + (size_t)(m + r * NGW) * 8 + 4) = (f32x4){d[4], d[5], d[6], d[7]}; }
            }
        }
    }
}

__device__ __forceinline__ void phase_prep(KArgs ap_, int l, const void* X, LAS unsigned char* lds, int tid, int lane, int wave) {
    KArgs ap = ap_; asm volatile("" : "+s"(ap)); KArgsRef a = *ap; tid = opq(tid); lane = opq(lane);
    unsigned char* ws = a.ws;
    if ((int)blockIdx.x < 128) s5_prep(ap, l, blockIdx.x >> 2, blockIdx.x & 3, lds, tid);
    LAS float* scr = (LAS float*)(lds + wave * 8448);
    const int gw = blockIdx.x * NWAVES + wave, NGW = gridDim.x * NWAVES;
    const float* w_in = a.in[2] + (size_t)l * DM * IN_COLS;
    constexpr int I_WIN = 16 * 120, I_WG = 16 * 96, I_P = 8 * 32, I_GLU = 8 * 16, I_WOUT = 16 * 32, I_FIN = 16 * 176, I_FOUT = 44 * 32, I_UP = 16, I_GUP = 32;
    constexpr int NITEMS = I_WIN + I_WG + 3 * I_P + I_GLU + I_WOUT + I_FIN + I_FOUT + 2 * I_UP + I_GUP;
    const int NGWT = 3 * 128 * NWAVES;
    const int gwt = (int)blockIdx.x >= 128 ? ((int)blockIdx.x - 128) * NWAVES + wave : 2 * 128 * NWAVES + (int)blockIdx.x * NWAVES + wave;
    const int nslot = (int)blockIdx.x >= 128 ? 2 : 1;
    for (int sl = 0; sl < nslot; ++sl)
    for (int it = gwt + sl * 128 * NWAVES; it < NITEMS; it += NGWT) {
        int r = it;
        if (r < I_WIN) { const int kb = r / 120, nb = r % 120, n0 = 32 * nb, c0 = n0 < 3328 ? n0 : n0 + 8; tr_item(w_in, IN_COLS, 64 * kb, c0, (bf16_t*)(ws + WS_WIN), 1024, n0, scr, lane); continue; } r -= I_WIN;
        if (r < I_WG) { const int kb = r / 96, nb = r % 96, n0 = 32 * nb; tr_item(w_in, IN_COLS, 64 * kb, 3848 + n0, (bf16_t*)(ws + WS_WG), 1024, n0, scr, lane); continue; } r -= I_WG;
        if (r < I_P) { tr_item(a.in[14] + (size_t)l * 512 * 1024, 1024, 64 * (r / 32), 32 * (r % 32), (bf16_t*)(ws + WS_PA), 512, 32 * (r % 32), scr, lane); continue; } r -= I_P;
        if (r < I_P) { tr_item(a.in[21] + (size_t)l * 512 * 1024, 1024, 64 * (r / 32), 32 * (r % 32), (bf16_t*)(ws + WS_PB), 512, 32 * (r % 32), scr, lane); continue; } r -= I_P;
        if (r < I_P) { tr_item(a.in[32] + (size_t)l * 512 * 1024, 1024, 64 * (r / 32), 32 * (r % 32), (bf16_t*)(ws + WS_PC), 512, 32 * (r % 32), scr, lane); continue; } r -= I_P;
        if (r < I_GLU) { tr_item(a.in[30] + (size_t)l * 512 * 512, 512, 64 * (r / 16), 32 * (r % 16), (bf16_t*)(ws + WS_GLU), 512, 32 * (r % 16), scr, lane); continue; } r -= I_GLU;
        if (r < I_WOUT) { tr_item(a.in[33] + (size_t)l * 1024 * 1024, 1024, 64 * (r / 32), 32 * (r % 32), (bf16_t*)(ws + WS_WOUT), 1024, 32 * (r % 32), scr, lane); continue; } r -= I_WOUT;
        if (r < I_FIN) { const int kb = r / 176, nb = r % 176, c0 = ((nb >> 2) & 1) * FFH + 128 * (nb >> 3) + 32 * (nb & 3);
            tr_item(a.in[35] + (size_t)l * 1024 * 2 * FFH, 2 * FFH, 64 * kb, c0, (bf16_t*)(ws + WS_FIN), 1024, 32 * nb, scr, lane); continue; } r -= I_FIN;
        if (r < I_FOUT) { tr_item(a.in[36] + (size_t)l * FFH * 1024, 1024, 64 * (r / 32), 32 * (r % 32), (bf16_t*)(ws + WS_FOUT), FFH, 32 * (r % 32), scr, lane); continue; } r -= I_FOUT;
        if (r < I_UP) { tr_item(a.in[5] + (size_t)l * 64 * 512, 512, 0, 32 * r, (bf16_t*)(ws + WS_WUP), 64, 32 * r, scr, lane); continue; } r -= I_UP;
        if (r < I_UP) { tr_item(a.in[7] + (size_t)l * 64 * 512, 512, 0, 32 * r, (bf16_t*)(ws + WS_AUP), 64, 32 * r, scr, lane); continue; } r -= I_UP;
        tr_item(a.in[8] + (size_t)l * 128 * 512, 512, 64 * (r / 16), 32 * (r % 16), (bf16_t*)(ws + WS_GUP), 128, 32 * (r % 16), scr, lane);
    }
    __syncthreads();
    LAS float* wdt = (LAS float*)lds;
    for (int e = tid; e < 8192; e += NTHR) { const int k = e >> 3, q = e & 7; wdt[q * 1024 + k] = w_in[(size_t)k * IN_COLS + 3328 + q]; }
    __syncthreads();
    if (l == 0) rmsnorm_rows<true, false>(X, a.in[1] + l * DM, (bf16_t*)(ws + WS_H), (float*)(ws + WS_DT), wdt, gw, NGW, lane);
    else rmsnorm_rows<true, true>(X, a.in[1] + l * DM, (bf16_t*)(ws + WS_H), (float*)(ws + WS_DT), wdt, gw, NGW, lane);
    __syncthreads();
}

__device__ __forceinline__ void rwkv_act_pass(KArgs ap_, int l, int tid) {
    KArgs ap = ap_; asm volatile("" : "+s"(ap)); KArgsRef a = *ap; tid = opq(tid);
    const bf16_t* proj = (const bf16_t*)(a.ws + WS_PROJ);
    bf16_t* ACT = (bf16_t*)a.out + (size_t)MTOK * 1024;
    const int gt = blockIdx.x * NTHR + tid, GT = gridDim.x * NTHR;
    const int vec = gt & 31, col = P_WD + 8 * vec;
    const float* mu = a.in[3] + l * 1792 + col;
    const f32x4 m0 = *(const f32x4*)mu, m1 = *(const f32x4*)(mu + 4);
    for (int i = gt; i < MTOK * 32; i += 4 * GT) {
        u32x4 c[4], p[4];
#pragma unroll
        for (int r = 0; r < 4; ++r) { const int row = (i + r * GT) >> 5; const bf16_t* pr = proj + (size_t)row * NPROJ + col;
            c[r] = *(const u32x4*)pr; p[r] = (row & (SEQ - 1)) ? *(const u32x4*)(pr - NPROJ) : (u32x4){0u, 0u, 0u, 0u}; }
#pragma unroll
        for (int r = 0; r < 4; ++r) { const int row = (i + r * GT) >> 5;
            float cu[8], pv[8], v[8]; unpack8(c[r], cu); unpack8(p[r], pv);
#pragma unroll
            for (int e = 0; e < 4; ++e) { v[e] = cu[e] + (pv[e] - cu[e]) * m0[e]; v[4 + e] = cu[4 + e] + (pv[4 + e] - cu[4 + e]) * m1[e]; }
            if (vec < 8) {
#pragma unroll
                for (int e = 0; e < 8; ++e) v[e] = ftanh(v[e]); }
            else if (vec >= 16) {
#pragma unroll
                for (int e = 0; e < 8; ++e) v[e] = sigm(v[e]); }
            *(u32x4*)(ACT + (size_t)row * 256 + 8 * vec) = pack8(v); }
    }
}

constexpr int R_CT = 16, R_NCH = SEQ / R_CT;
constexpr int R_BW = 0, R_BA = 9216, R_BG = 18432, R_AW = 35840, R_AA = 38144, R_AG = 40448, R_VEC2 = 44800, R_VEC3 = 85760, R_BON = 110336, R_INV = 111104, R_OB = 111168;
struct StepV { f32x4 n0, n1, w0, w1, b0, b1, k0, k1, r0, r1; f32x2 vv; };
__device__ __forceinline__ StepV rw_load(const LAS float* v2, const LAS float* vvb, int t, int jj, int rp) {
    StepV s; const LAS float* p = v2 + t * 64 + 8 * jj;
    s.n0 = *(const LAS f32x4*)(p); s.n1 = *(const LAS f32x4*)(p + 4);
    s.w0 = *(const LAS f32x4*)(p + 1024); s.w1 = *(const LAS f32x4*)(p + 1028);
    s.b0 = *(const LAS f32x4*)(p + 2048); s.b1 = *(const LAS f32x4*)(p + 2052);
    s.k0 = *(const LAS f32x4*)(p + 3072); s.k1 = *(const LAS f32x4*)(p + 3076);
    s.r0 = *(const LAS f32x4*)(p + 4096); s.r1 = *(const LAS f32x4*)(p + 4100);
    s.vv = *(const LAS f32x2*)(vvb + t * 64 + 2 * rp);
    return s;
}
template <int CTRL> __device__ __forceinline__ float dppb(float x) { return __builtin_bit_cast(float, __builtin_amdgcn_update_dpp(0, __builtin_bit_cast(int, x), CTRL, 0xf, 0xf, true)); }
__device__ __forceinline__ float red8b(float x) { x += dppb<0xB1>(x); x += dppb<0x4E>(x); x += dppb<0x141>(x); return x; }
__device__ __forceinline__ void rw_step(f32x2 (&S)[8], const StepV& s, LAS float* ob, int t, int jj, int rp) {
    const f32x2 nA[4] = {{s.n0.x, s.n0.y}, {s.n0.z, s.n0.w}, {s.n1.x, s.n1.y}, {s.n1.z, s.n1.w}};
    const f32x2 wA[4] = {{s.w0.x, s.w0.y}, {s.w0.z, s.w0.w}, {s.w1.x, s.w1.y}, {s.w1.z, s.w1.w}};
    const f32x2 bA[4] = {{s.b0.x, s.b0.y}, {s.b0.z, s.b0.w}, {s.b1.x, s.b1.y}, {s.b1.z, s.b1.w}};
    const f32x2 kA[4] = {{s.k0.x, s.k0.y}, {s.k0.z, s.k0.w}, {s.k1.x, s.k1.y}, {s.k1.z, s.k1.w}};
    const f32x2 rA[4] = {{s.r0.x, s.r0.y}, {s.r0.z, s.r0.w}, {s.r1.x, s.r1.y}, {s.r1.z, s.r1.w}};
    f32x2 a0 = S[0] * nA[0], a1 = S[4] * nA[0];
#pragma unroll
    for (int i = 1; i < 4; ++i) { a0 += S[i] * nA[i]; a1 += S[4 + i] * nA[i]; }
    float sa0 = red8b(a0.x + a0.y), sa1 = red8b(a1.x + a1.y);
    const float v0 = s.vv.x, v1 = s.vv.y;
#pragma unroll
    for (int i = 0; i < 4; ++i) { S[i] = S[i] * wA[i] + (bA[i] * sa0 + kA[i] * v0); S[4 + i] = S[4 + i] * wA[i] + (bA[i] * sa1 + kA[i] * v1); }
    f32x2 o0 = S[0] * rA[0], o1 = S[4] * rA[0];
#pragma unroll
    for (int i = 1; i < 4; ++i) { o0 += S[i] * rA[i]; o1 += S[4 + i] * rA[i]; }
    f32x2 o; o.x = red8b(o0.x + o0.y); o.y = red8b(o1.x + o1.y);
    if (jj == 0) *(LAS f32x2*)(ob + t * 64 + 2 * rp) = o;
}
__device__ __forceinline__ void rwkv_unit(KArgs ap_, int l, int b, int h, LAS unsigned char* lds, int tid, int lane, int wave) {
    KArgs ap = ap_; asm volatile("" : "+s"(ap)); KArgsRef a = *ap; tid = opq(tid); lane = opq(lane);
    unsigned char* ws = a.ws;
    const bf16_t* proj = (const bf16_t*)(ws + WS_PROJ);
    bf16_t* Ya = (bf16_t*)(ws + WS_YA);
    LAS bf16_t* BW = (LAS bf16_t*)(lds + R_BW); LAS bf16_t* BA = (LAS bf16_t*)(lds + R_BA); LAS bf16_t* BG = (LAS bf16_t*)(lds + R_BG);
    LAS bf16_t* AW = (LAS bf16_t*)(lds + R_AW); LAS bf16_t* AA = (LAS bf16_t*)(lds + R_AA); LAS bf16_t* AG = (LAS bf16_t*)(lds + R_AG);
    LAS float* VEC2 = (LAS float*)(lds + R_VEC2);
    LAS float* VEC3 = (LAS float*)(lds + R_VEC3);
    LAS float* BONP = (LAS float*)(lds + R_BON);
    LAS float* INV = (LAS float*)(lds + R_INV);
    LAS float* OBB = (LAS float*)(lds + R_OB);
    const float* mu = a.in[3] + l * 1792;
    const float* w0 = a.in[4] + l * 512 + 64 * h; const float* a0 = a.in[6] + l * 512 + 64 * h;
    const float* k_k = a.in[9] + l * 512 + 64 * h; const float* k_a = a.in[10] + l * 512 + 64 * h; const float* r_k = a.in[11] + l * 512 + 64 * h;
    const float* ln_g = a.in[12] + l * 512 + 64 * h; const float* ln_b = a.in[13] + l * 512 + 64 * h;
    { const bf16_t* wup = (const bf16_t*)(ws + WS_WUP) + (size_t)64 * h * 64; const bf16_t* aup = (const bf16_t*)(ws + WS_AUP) + (size_t)64 * h * 64; const bf16_t* gup = (const bf16_t*)(ws + WS_GUP) + (size_t)64 * h * 128;
      { const int n = tid >> 3, c = tid & 7; *(LAS u32x4*)(BW + n * 72 + 8 * c) = *(const u32x4*)(wup + n * 64 + 8 * c); *(LAS u32x4*)(BA + n * 72 + 8 * c) = *(const u32x4*)(aup + n * 64 + 8 * c); }
      for (int e = tid; e < 1024; e += NTHR) { const int n = e >> 4, c = e & 15; *(LAS u32x4*)(BG + n * 136 + 8 * c) = *(const u32x4*)(gup + n * 128 + 8 * c); } }
    const bool is_scan = wave < 4;
    const size_t rowbase = (size_t)b * SEQ;
    f32x2 S[8];
#pragma unroll
    for (int i = 0; i < 8; ++i) S[i] = (f32x2){0.f, 0.f};
    const int rp = (tid >> 3) & 31, jj = tid & 7;
    const int pt = tid & 255, pw = wave & 3;
    const bf16_t* ACT = (const bf16_t*)a.out + (size_t)MTOK * 1024;
    u32x4 RC[2], RP[2], CC[2];
#pragma unroll
    for (int i = 0; i < 2; ++i) { RC[i] = (u32x4){0u, 0u, 0u, 0u}; RP[i] = (u32x4){0u, 0u, 0u, 0u}; CC[i] = (u32x4){0u, 0u, 0u, 0u}; }
    __syncthreads();

#define RW_LD(IDX, KIND, tok, colv, lcv, MU, DSTF, DSTB, LDB) do { \
    const int t_ = (cn_) * R_CT + (tok); const bf16_t* pr_ = proj + (rowbase + t_) * NPROJ + (colv); \
    RC[IDX] = *(const u32x4*)pr_; RP[IDX] = t_ > 0 ? *(const u32x4*)(pr_ - NPROJ) : (u32x4){0u, 0u, 0u, 0u}; } while (0)
#define RW_PAIR(IDX, KIND, tok, colv, lcv, MU, DSTF, DSTB, LDB) do { \
    float cur_[8], prv_[8], v_[8]; unpack8(RC[IDX], cur_); unpack8(RP[IDX], prv_); \
    { const f32x4 m0_ = *(const f32x4*)(mu + (colv)), m1_ = *(const f32x4*)(mu + (colv) + 4); \
      _Pragma("unroll") for (int e = 0; e < 4; ++e) { v_[e] = cur_[e] + (prv_[e] - cur_[e]) * m0_[e]; v_[4 + e] = cur_[4 + e] + (prv_[4 + e] - cur_[4 + e]) * m1_[e]; } } \
    if (KIND <= 2) { LAS float* d_ = (DSTF) + (tok) * 64 + (lcv); *(LAS f32x4*)d_ = (f32x4){v_[0], v_[1], v_[2], v_[3]}; *(LAS f32x4*)(d_ + 4) = (f32x4){v_[4], v_[5], v_[6], v_[7]}; \
        if (KIND == 1) { const f32x4 k0_ = *(const f32x4*)(k_k + (lcv)), k1_ = *(const f32x4*)(k_k + (lcv) + 4); float q_ = 0.f; _Pragma("unroll") for (int e = 0; e < 4; ++e) { const float x_ = v_[e] * k0_[e], y_ = v_[4 + e] * k1_[e]; q_ += x_ * x_ + y_ * y_; } q_ = red8b(q_); if (((lcv) >> 3) == 0) INV[tok] = __builtin_amdgcn_rsqf(fmaxf(q_, 1e-24f)); } } \
    else { if (KIND == 3) { _Pragma("unroll") for (int e = 0; e < 8; ++e) v_[e] = ftanh(v_[e]); } \
        if (KIND == 5) { _Pragma("unroll") for (int e = 0; e < 8; ++e) v_[e] = sigm(v_[e]); } \
        *(LAS u32x4*)((DSTB) + (tok) * (LDB) + (lcv)) = pack8(v_); } } while (0)
#define RW_FORPAIRS(OP) do { const int ln = opq(lane); \
    if (pw == 0) { _Pragma("unroll") for (int i = 0; i < 2; ++i) { const int tok = (ln >> 3) + 8 * i, lc = 8 * (ln & 7); OP(i, 0, tok, P_R + 64 * h + lc, lc, muA, v2 + 4096, AW, 72); } } \
    else if (pw == 1) { _Pragma("unroll") for (int i = 0; i < 2; ++i) { const int tok = (ln >> 3) + 8 * i, lc = 8 * (ln & 7); OP(i, 2, tok, P_V + 64 * h + lc, lc, muA, v3, AW, 72); } } \
    else { const int tok = (ln >> 3) + 8 * (pw - 2), lc = 8 * (ln & 7); OP(0, 1, tok, P_K + 64 * h + lc, lc, muA, v2 + 3072, AW, 72); } \
    } while (0)
#define RW_CPLD(cn) do { const int pt_ = opq(pt); _Pragma("unroll") for (int i = 0; i < 2; ++i) { const int ix_ = pt_ + 256 * i; \
        CC[i] = *(const u32x4*)(ACT + (rowbase + (cn) * R_CT + (ix_ >> 5)) * 256 + 8 * (ix_ & 31)); } } while (0)
#define RW_CPST() do { const int pt_ = opq(pt); _Pragma("unroll") for (int i = 0; i < 2; ++i) { const int ix_ = pt_ + 256 * i, tk_ = ix_ >> 5, vc_ = ix_ & 31; \
        const int ad_ = vc_ < 8 ? R_AW + tk_ * 144 + 16 * vc_ : (vc_ < 16 ? R_AA + tk_ * 144 + 16 * (vc_ - 8) : R_AG + tk_ * 272 + 16 * (vc_ - 16)); \
        *(LAS u32x4*)(lds + ad_) = CC[i]; } } while (0)
#define RW_LOAD(cn) do { const int cn_ = (cn); LAS float* v2 = nullptr; LAS float* v3 = nullptr; (void)v2; (void)v3; RW_FORPAIRS(RW_LD); RW_CPLD(cn_); } while (0)
#define RW_PREP1(cn) do { const int cn_ = (cn); (void)cn_; \
    LAS float* v2 = VEC2 + (cn_ & 1) * 5120; LAS float* v3 = VEC3 + (cn_ % 3) * 2048; RW_FORPAIRS(RW_PAIR); RW_CPST(); } while (0)

#define RW_PREP2(cn) do { const int ln2 = opq(lane); const int r16 = ln2 & 15, q4 = ln2 >> 4, kq = 8 * q4, nn = 16 * pw + r16; \
    const float w0n = w0[nn], a0n = a0[nn], kkn = k_k[nn], kan = k_a[nn], rkn = r_k[nn]; \
    LAS float* v2 = VEC2 + ((cn) & 1) * 5120; LAS float* v3 = VEC3 + ((cn) % 3) * 2048; LAS float* bp = BONP + ((cn) % 3) * 64; \
    const f32x4 z4_ = {0.f, 0.f, 0.f, 0.f}; \
    f32x4 cw = MFMA16(ldsfrag(AW, r16, 72, kq), ldsfrag(BW, 16 * pw + r16, 72, kq), z4_); cw = MFMA16(ldsfrag(AW, r16, 72, 32 + kq), ldsfrag(BW, 16 * pw + r16, 72, 32 + kq), cw); \
    f32x4 ca = MFMA16(ldsfrag(AA, r16, 72, kq), ldsfrag(BA, 16 * pw + r16, 72, kq), z4_); ca = MFMA16(ldsfrag(AA, r16, 72, 32 + kq), ldsfrag(BA, 16 * pw + r16, 72, 32 + kq), ca); \
    f32x4 cgt = MFMA16(ldsfrag(AG, r16, 136, kq), ldsfrag(BG, 16 * pw + r16, 136, kq), z4_); \
    _Pragma("unroll") for (int ks = 1; ks < 4; ++ks) cgt = MFMA16(ldsfrag(AG, r16, 136, 32 * ks + kq), ldsfrag(BG, 16 * pw + r16, 136, 32 * ks + kq), cgt); \
    _Pragma("unroll") for (int j = 0; j < 4; ++j) { const int tok = 4 * q4 + j; \
        const float wv = __expf(-0.6065306597f * sigm(w0n + cw[j])); const float av = sigm(a0n + ca[j]); \
        const float kr = v2[3072 + tok * 64 + nn], rr = v2[4096 + tok * 64 + nn], inv = INV[tok]; \
        const float kk = kr * kkn * inv, kp = kr * (1.f + (av - 1.f) * kan); \
        v2[tok * 64 + nn] = -kk; v2[1024 + tok * 64 + nn] = wv; v2[2048 + tok * 64 + nn] = kk * av; v2[3072 + tok * 64 + nn] = kp; \
        v3[1024 + tok * 64 + nn] = cgt[j]; \
        float bs = rr * kp * rkn; bs = red16(bs); if (r16 == 0) bp[tok * 4 + pw] = bs; } \
    } while (0)

#define RW_FIN(cf) do { \
    const LAS float* ob = OBB + ((cf) & 1) * 1024; const LAS float* v3 = VEC3 + ((cf) % 3) * 2048; const LAS float* bp = BONP + ((cf) % 3) * 64; \
    const int pt_ = opq(pt); const int tok = pt_ >> 4, sub = pt_ & 15, n0 = 4 * sub; \
    const f32x4 o = *(const LAS f32x4*)(ob + tok * 64 + n0); \
    float s = (o.x + o.y) + (o.z + o.w); s = red16(s); \
    const float mean = s * (1.f / 64.f); const f32x4 d = o - mean; \
    float q = (d.x * d.x + d.y * d.y) + (d.z * d.z + d.w * d.w); q = red16(q); \
    const float rstd = __builtin_amdgcn_rsqf(q * (1.f / 64.f) + 64e-5f); \
    const f32x4 lg = *(const f32x4*)(ln_g + n0), lb = *(const f32x4*)(ln_b + n0); \
    const f32x4 vv = *(const LAS f32x4*)(v3 + tok * 64 + n0), gg = *(const LAS f32x4*)(v3 + 1024 + tok * 64 + n0); \
    const f32x4 bq = *(const LAS f32x4*)(bp + tok * 4); const float bon = (bq.x + bq.y) + (bq.z + bq.w); \
    const f32x4 y = (d * rstd * lg + lb + vv * bon) * gg; \
    u32x2 w; w.x = pk2(y.x, y.y); w.y = pk2(y.z, y.w); \
    *(u32x2*)(Ya + (rowbase + (cf) * R_CT + tok) * 512 + 64 * h + n0) = w; } while (0)

#define RW_SCAN8(c, t0) do { \
    const int a2_ = opq(R_VEC2 + ((c) & 1) * 20480 + 32 * jj), a3_ = opq(R_VEC3 + ((c) % 3) * 8192 + 8 * rp), ao_ = opq(R_OB + ((c) & 1) * 4096 + 8 * rp); \
    const LAS float* v2 = (const LAS float*)(lds + a2_); const LAS float* vvb = (const LAS float*)(lds + a3_); LAS float* ob = (LAS float*)(lds + ao_); \
    StepV cur = rw_load(v2, vvb, (t0), 0, 0); \
    _Pragma("unroll") for (int i = 0; i < 8; ++i) { StepV nxt; if (i < 7) nxt = rw_load(v2, vvb, (t0) + i + 1, 0, 0); \
        rw_step(S, cur, ob, (t0) + i, jj, 0); if (i < 7) cur = nxt; } } while (0)

    if (!is_scan) { RW_LOAD(0); RW_PREP1(0); RW_LOAD(1); }
    __syncthreads();
    if (!is_scan) RW_PREP2(0);
    __syncthreads();
#pragma unroll 1
    for (int c = 0; c < R_NCH; ++c) {
        if (is_scan) { RW_SCAN8(c, 0); } else { if (c + 1 < R_NCH) RW_PREP1(c + 1); if (c + 2 < R_NCH) RW_LOAD(c + 2); }
        __syncthreads();
        if (is_scan) { RW_SCAN8(c, 8); } else { if (c + 1 < R_NCH) RW_PREP2(c + 1); if (c >= 1) RW_FIN(c - 1); }
        __syncthreads();
    }
    if (!is_scan) RW_FIN(R_NCH - 1);
    __syncthreads();
#undef RW_PREP1
#undef RW_LOAD
#undef RW_CPLD
#undef RW_CPST
#undef RW_LD
#undef RW_PAIR
#undef RW_FORPAIRS
#undef RW_PREP2
#undef RW_FIN
#undef RW_SCAN8
}

constexpr int S_LD = 136;
constexpr int S_CS = 0, S_BS = 34816, S_BT = 69632, S_XT = 104448, S_SB = 121856, S_ACS = 139264, S_DTV = 139776;
__device__ __forceinline__ void ssd_unit(KArgs ap_, int l, int b, int h, LAS unsigned char* lds, int tid, int lane, int wave) {
    KArgs ap = ap_; asm volatile("" : "+s"(ap)); KArgsRef a = *ap; tid = opq(tid); lane = opq(lane);
    unsigned char* ws = a.ws;
    const bf16_t* proj = (const bf16_t*)(ws + WS_PROJ);
    const float* dtraw = (const float*)(ws + WS_DT);
    bf16_t* Yb = (bf16_t*)(ws + WS_YB);
    LAS bf16_t* Cs = (LAS bf16_t*)(lds + S_CS); LAS bf16_t* Bs = (LAS bf16_t*)(lds + S_BS); LAS bf16_t* BT = (LAS bf16_t*)(lds + S_BT);
    LAS bf16_t* XT = (LAS bf16_t*)(lds + S_XT); LAS bf16_t* SB = (LAS bf16_t*)(lds + S_SB);
    LAS float* ACS = (LAS float*)(lds + S_ACS); LAS float* DTV = (LAS float*)(lds + S_DTV);
    const int g = h >> 2;
    const float* cw = a.in[15] + (size_t)l * 4 * 1024; const float* cb = a.in[16] + l * 1024;
    const float dtb = a.in[17][l * 8 + h], Ah = -expf(a.in[18][l * 8 + h]), Dh = a.in[19][l * 8 + h];
    const size_t rowbase = (size_t)b * SEQ;
    const int r16 = lane & 15, q4 = lane >> 4, kq = 8 * q4;
    f32x4 st[4];
#pragma unroll
    for (int i = 0; i < 4; ++i) st[i] = (f32x4){0.f, 0.f, 0.f, 0.f};
    for (int e = tid; e < 64 * S_LD / 2; e += NTHR) ((LAS unsigned*)SB)[e] = 0u;
    __syncthreads();
    for (int t0 = 0; t0 < SEQ; t0 += 128) {
        if (tid < 128) DTV[tid] = softplusf(dtraw[(rowbase + t0 + tid) * 8 + h] + dtb);
        __syncthreads();
        if (wave == 0) { const float a0 = DTV[2 * lane] * Ah, a1 = DTV[2 * lane + 1] * Ah; float s = a0 + a1;
#pragma unroll
            for (int o = 1; o < 64; o <<= 1) { const float t = __shfl_up(s, o); if (lane >= o) s += t; }
            ACS[2 * lane + 1] = s; ACS[2 * lane] = s - a1; }
        __syncthreads();
        const float acsL = ACS[127];
        for (int item = tid; item < 640; item += NTHR) {
            const int tg = item / 40, vec = item % 40, l0 = 8 * tg;
            int col, kind, lc;
            if (vec < 8) { kind = 0; lc = 8 * vec; col = P_XS + 64 * h + lc; }
            else if (vec < 24) { kind = 1; lc = 8 * (vec - 8); col = P_B + 128 * g + lc; }
            else { kind = 2; lc = 8 * (vec - 24); col = P_C + 128 * g + lc; }
            const int cc = col - P_XS;
            u32x4 in[11];
#pragma unroll
            for (int i = 0; i < 11; ++i) { const int t = t0 + l0 - 3 + i; in[i] = t >= 0 ? *(const u32x4*)(proj + (rowbase + t) * NPROJ + col) : (u32x4){0u, 0u, 0u, 0u}; }
            float wj[4][8], bias[8];
#pragma unroll
            for (int j = 0; j < 4; ++j) { const f32x4 x0 = *(const f32x4*)(cw + j * 1024 + cc), x1 = *(const f32x4*)(cw + j * 1024 + cc + 4);
                wj[j][0] = x0.x; wj[j][1] = x0.y; wj[j][2] = x0.z; wj[j][3] = x0.w; wj[j][4] = x1.x; wj[j][5] = x1.y; wj[j][6] = x1.z; wj[j][7] = x1.w; }
            { const f32x4 x0 = *(const f32x4*)(cb + cc), x1 = *(const f32x4*)(cb + cc + 4); bias[0] = x0.x; bias[1] = x0.y; bias[2] = x0.z; bias[3] = x0.w; bias[4] = x1.x; bias[5] = x1.y; bias[6] = x1.z; bias[7] = x1.w; }
            float out[8][8];
#pragma unroll
            for (int tt = 0; tt < 8; ++tt)
#pragma unroll
                for (int e = 0; e < 8; ++e) out[tt][e] = bias[e];
#pragma unroll
            for (int i = 0; i < 11; ++i) { float x[8]; unpack8(in[i], x);
#pragma unroll
                for (int j = 0; j < 4; ++j) { const int tt = i - j;
                    if (tt >= 0 && tt < 8) {
#pragma unroll
                        for (int e = 0; e < 8; ++e) out[tt][e] += wj[j][e] * x[e]; } } }
#pragma unroll
            for (int tt = 0; tt < 8; ++tt)
#pragma unroll
                for (int e = 0; e < 8; ++e) out[tt][e] = out[tt][e] * sigm(out[tt][e]);
            if (kind == 0) {
                float dtl[8];
#pragma unroll
                for (int tt = 0; tt < 8; ++tt) dtl[tt] = DTV[l0 + tt];
#pragma unroll
                for (int e = 0; e < 8; ++e) { float c[8];
#pragma unroll
                    for (int tt = 0; tt < 8; ++tt) c[tt] = out[tt][e] * dtl[tt];
                    *(LAS u32x4*)(XT + (lc + e) * S_LD + l0) = pack8(c); }
            } else if (kind == 1) {
                float dec[8];
#pragma unroll
                for (int tt = 0; tt < 8; ++tt) dec[tt] = __expf(acsL - ACS[l0 + tt]);
#pragma unroll
                for (int tt = 0; tt < 8; ++tt) *(LAS u32x4*)(Bs + (l0 + tt) * S_LD + lc) = pack8(out[tt]);
#pragma unroll
                for (int e = 0; e < 8; ++e) { float c[8];
#pragma unroll
                    for (int tt = 0; tt < 8; ++tt) c[tt] = out[tt][e] * dec[tt];
                    *(LAS u32x4*)(BT + (lc + e) * S_LD + l0) = pack8(c); }
            } else {
#pragma unroll
                for (int tt = 0; tt < 8; ++tt) *(LAS u32x4*)(Cs + (l0 + tt) * S_LD + lc) = pack8(out[tt]);
            }
        }
        __syncthreads();
        f32x4 sc[8];
#pragma unroll
        for (int i = 0; i < 8; ++i) sc[i] = (f32x4){0.f, 0.f, 0.f, 0.f};
#pragma unroll
        for (int ks = 0; ks < 4; ++ks) { const bf16x8 af = ldsfrag(Cs, 16 * wave + r16, S_LD, 32 * ks + kq);
#pragma unroll
            for (int s = 0; s < 8; ++s) sc[s] = MFMA16(af, ldsfrag(Bs, 16 * s + r16, S_LD, 32 * ks + kq), sc[s]); }
        __syncthreads();
        {
            float al[4], dl[4];
#pragma unroll
            for (int j = 0; j < 4; ++j) { al[j] = ACS[16 * wave + 4 * q4 + j]; dl[j] = Dh / DTV[16 * wave + 4 * q4 + j]; }
#pragma unroll
            for (int s = 0; s < 8; ++s) { const int sidx = 16 * s + r16; const float as = ACS[sidx];
#pragma unroll
                for (int j = 0; j < 4; ++j) { const int lidx = 16 * wave + 4 * q4 + j;
                    float v = sidx <= lidx ? sc[s][j] * __expf(al[j] - as) : 0.f; if (sidx == lidx) v += dl[j];
                    Bs[lidx * S_LD + sidx] = (bf16_t)f2bf(v); } }
        }
        __syncthreads();
        {
            f32x4 yd[4], yo[4];
#pragma unroll
            for (int i = 0; i < 4; ++i) { yd[i] = (f32x4){0.f, 0.f, 0.f, 0.f}; yo[i] = (f32x4){0.f, 0.f, 0.f, 0.f}; }
#pragma unroll
            for (int ks = 0; ks < 4; ++ks) { const bf16x8 am = ldsfrag(Bs, 16 * wave + r16, S_LD, 32 * ks + kq), ac = ldsfrag(Cs, 16 * wave + r16, S_LD, 32 * ks + kq);
#pragma unroll
                for (int pt = 0; pt < 4; ++pt) { yd[pt] = MFMA16(am, ldsfrag(XT, 16 * pt + r16, S_LD, 32 * ks + kq), yd[pt]);
                    yo[pt] = MFMA16(ac, ldsfrag(SB, 16 * pt + r16, S_LD, 32 * ks + kq), yo[pt]); } }
#pragma unroll
            for (int j = 0; j < 4; ++j) { const int lidx = 16 * wave + 4 * q4 + j; const float ea = __expf(ACS[lidx]);
                const size_t row = rowbase + t0 + lidx;
#pragma unroll
                for (int pt = 0; pt < 4; ++pt) { const int p = 16 * pt + r16;
                    const float z = bf2f(proj[row * NPROJ + P_Z + 64 * h + p]);
                    const float y = (yd[pt][j] + ea * yo[pt][j]) * (z * sigm(z));
                    Yb[row * 512 + 64 * h + p] = (bf16_t)f2bf(y); } }
        }
        {
            const float dec = __expf(acsL);
#pragma unroll
            for (int pt = 0; pt < 4; ++pt) st[pt] = st[pt] * dec;
#pragma unroll
            for (int ks = 0; ks < 4; ++ks) { const bf16x8 bf = ldsfrag(BT, 16 * wave + r16, S_LD, 32 * ks + kq);
#pragma unroll
                for (int pt = 0; pt < 4; ++pt) st[pt] = MFMA16(ldsfrag(XT, 16 * pt + r16, S_LD, 32 * ks + kq), bf, st[pt]); }
        }
        __syncthreads();
#pragma unroll
        for (int pt = 0; pt < 4; ++pt)
#pragma unroll
            for (int j = 0; j < 4; ++j) SB[(16 * pt + 4 * q4 + j) * S_LD + 16 * wave + r16] = (bf16_t)f2bf(st[pt][j]);
    }
    __syncthreads();
}

constexpr int F_U = 0, F_SP = 67584;
__device__ __forceinline__ float gelu_tanh(float x) { const float u = 0.7978845608028654f * (x + 0.044715f * x * x * x); return 0.5f * x * (1.f + ftanh(u)); }
__device__ __forceinline__ void s5_unit(KArgs ap_, int l, int b, int g, LAS unsigned char* lds, int tid, int lane, int wave) {
    KArgs ap = ap_; asm volatile("" : "+s"(ap)); KArgsRef a = *ap; tid = opq(tid); lane = opq(lane);
    unsigned char* ws = a.ws;
    const bf16_t* proj = (const bf16_t*)(ws + WS_PROJ);
    bf16_t* ZG = (bf16_t*)(ws + WS_ZG);
    const bf16_t* tm = (const bf16_t*)(ws + WS_TM) + (size_t)g * 384 * 256;
    const bf16_t* m3 = (const bf16_t*)(ws + WS_M3) + (size_t)g * 256 * 128;
    const float* A16 = (const float*)(ws + WS_A16) + g * 128;
    LAS bf16_t* U = (LAS bf16_t*)(lds + F_U); LAS float* ST = (LAS float*)(lds + F_U); LAS bf16_t* SP = (LAS bf16_t*)(lds + F_SP);
    LAS unsigned char* ZL = lds + F_U;
    const size_t rowbase = (size_t)b * SEQ;
    const int r16 = lane & 15, q4 = lane >> 4, kq = 8 * q4;
    u32x4 ur[8];
#pragma unroll
    for (int j = 0; j < 8; ++j) { const int i = tid + NTHR * j, t = i >> 1, hf = i & 1; ur[j] = *(const u32x4*)(proj + (rowbase + t) * NPROJ + P_U + 16 * g + 8 * hf); }
    bf16x8 bf[8][3];
#pragma unroll
    for (int ks = 0; ks < 4; ++ks) { const int k = 32 * ks + kq;
        bf[ks][0] = *(const bf16x8*)(tm + (size_t)(32 * wave + r16) * 256 + k); bf[ks][1] = *(const bf16x8*)(tm + (size_t)(32 * wave + 16 + r16) * 256 + k); bf[ks][2] = *(const bf16x8*)(tm + (size_t)(256 + 16 * wave + r16) * 256 + k); }
#pragma unroll
    for (int j = 0; j < 8; ++j) { const int i = tid + NTHR * j, t = i >> 1, hf = i & 1; *(LAS u32x4*)(U + (t >> 4) * 264 + (t & 15) * 16 + 8 * hf) = ur[j]; }
    asm volatile("" ::: "memory");
#pragma unroll
    for (int ks = 4; ks < 8; ++ks) { const int k = 32 * ks + kq;
        bf[ks][0] = *(const bf16x8*)(tm + (size_t)(32 * wave + r16) * 256 + k); bf[ks][1] = *(const bf16x8*)(tm + (size_t)(32 * wave + 16 + r16) * 256 + k); bf[ks][2] = *(const bf16x8*)(tm + (size_t)(256 + 16 * wave + r16) * 256 + k); }
    __syncthreads();
    f32x4 ay[8][2], as_[8];
#pragma unroll
    for (int m = 0; m < 8; ++m) { ay[m][0] = (f32x4){0.f, 0.f, 0.f, 0.f}; ay[m][1] = (f32x4){0.f, 0.f, 0.f, 0.f}; as_[m] = (f32x4){0.f, 0.f, 0.f, 0.f}; }
#pragma unroll
    for (int ks = 0; ks < 8; ++ks) { const int k = 32 * ks + kq;
#pragma unroll
        for (int m = 0; m < 8; ++m) { const bf16x8 af = ldsfrag(U, 16 * m + r16, 264, k);
            ay[m][0] = MFMA16(af, bf[ks][0], ay[m][0]); ay[m][1] = MFMA16(af, bf[ks][1], ay[m][1]); as_[m] = MFMA16(af, bf[ks][2], as_[m]); } }
    bf16x8 mf[4][2];
#pragma unroll
    for (int ks = 0; ks < 4; ++ks) { const int k = 32 * ks + kq;
        mf[ks][0] = *(const bf16x8*)(m3 + (size_t)(32 * wave + r16) * 128 + k); mf[ks][1] = *(const bf16x8*)(m3 + (size_t)(32 * wave + 16 + r16) * 128 + k); }
    __syncthreads();
#pragma unroll
    for (int m = 0; m < 8; ++m)
#pragma unroll
        for (int j = 0; j < 4; ++j) ST[(16 * m + 4 * q4 + j) * 128 + 16 * wave + r16] = as_[m][j];
    __syncthreads();
    if (tid < 64) { const int n = tid; const float ar = A16[2 * n], ai = A16[2 * n + 1]; float sr = 0.f, si = 0.f;
#pragma unroll 8
        for (int c = 0; c < 128; ++c) { *(LAS unsigned*)(SP + c * 136 + 2 * n) = pk2(sr, si);
            const f32x2 t = *(LAS f32x2*)(ST + c * 128 + 2 * n);
            const float nr = ar * sr - ai * si + t.x, ni = ar * si + ai * sr + t.y; sr = nr; si = ni; } }
    __syncthreads();
#pragma unroll
    for (int ks = 0; ks < 4; ++ks) { const int k = 32 * ks + kq;
#pragma unroll
        for (int m = 0; m < 8; ++m) { const bf16x8 af = ldsfrag(SP, 16 * m + r16, 136, k);
            ay[m][0] = MFMA16(af, mf[ks][0], ay[m][0]); ay[m][1] = MFMA16(af, mf[ks][1], ay[m][1]); } }
    __syncthreads();
#pragma unroll
    for (int m = 0; m < 8; ++m)
#pragma unroll
        for (int e = 0; e < 2; ++e)
#pragma unroll
            for (int j = 0; j < 4; ++j) { const int c = 16 * m + 4 * q4 + j, tok = 16 * c + 2 * wave + e;
                *(LAS bf16_t*)(ZL + tok * 32 + c * 32 + 2 * r16) = (bf16_t)f2bf(gelu_tanh(ay[m][e][j])); }
    __syncthreads();
#pragma unroll
    for (int j = 0; j < 8; ++j) { const int i = tid + NTHR * j, t = i >> 1, hf = i & 1;
        *(u32x4*)(ZG + (rowbase + t) * 512 + 16 * g + 8 * hf) = *(const LAS u32x4*)(ZL + t * 32 + (t >> 4) * 32 + 16 * hf); }
    __syncthreads();
}

__device__ __forceinline__ void ssd_norm_rows(KArgs ap_, int l, int gw, int NGW, int lane) {
    KArgs ap = ap_; asm volatile("" : "+s"(ap)); KArgsRef a = *ap; lane = opq(lane);
    bf16_t* Yb = (bf16_t*)(a.ws + WS_YB);
    const float* ng = a.in[20] + l * 512 + 8 * lane;
    const f32x4 g0 = *(const f32x4*)ng, g1 = *(const f32x4*)(ng + 4);
    for (int m = gw; m < MTOK; m += 4 * NGW) {
        u32x4 raw[4];
#pragma unroll
        for (int r = 0; r < 4; ++r) raw[r] = *(const u32x4*)(Yb + (size_t)(m + r * NGW) * 512 + 8 * lane);
#pragma unroll
        for (int r = 0; r < 4; ++r) {
            float v[8]; unpack8(raw[r], v);
            float s = 0.f;
#pragma unroll
            for (int e = 0; e < 8; ++e) s += v[e] * v[e];
            s = red32(s);
            const float rinv = __builtin_amdgcn_rsqf(s * (1.f / 256.f) + 1e-5f);
            v[0] *= rinv * g0.x; v[1] *= rinv * g0.y; v[2] *= rinv * g0.z; v[3] *= rinv * g0.w; v[4] *= rinv * g1.x; v[5] *= rinv * g1.y; v[6] *= rinv * g1.z; v[7] *= rinv * g1.w;
            *(u32x4*)(Yb + (size_t)(m + r * NGW) * 512 + 8 * lane) = pack8(v);
        }
    }
}

__device__ __forceinline__ void final_norm_rows(const bf16_t* X, float* O, const float* gamma, int gw, int NGW, int lane) {
    lane = opq(lane);
    f32x4 g[4];
#pragma unroll
    for (int j = 0; j < 4; ++j) g[j] = *(const f32x4*)(gamma + 4 * lane + 256 * j);
    for (int m = gw; m < MTOK; m += 4 * NGW) {
        f32x4 v[4][4]; float s[4];
#pragma unroll
        for (int r = 0; r < 4; ++r) { const bf16_t* xr = X + (size_t)(m + r * NGW) * DM + 4 * lane; s[r] = 0.f;
#pragma unroll
            for (int j = 0; j < 4; ++j) { const u32x2 w = *(const u32x2*)(xr + 256 * j); v[r][j] = (f32x4){bf_lo(w.x), bf_hi(w.x), bf_lo(w.y), bf_hi(w.y)};
                s[r] += (v[r][j].x * v[r][j].x + v[r][j].y * v[r][j].y) + (v[r][j].z * v[r][j].z + v[r][j].w * v[r][j].w); } }
#pragma unroll
        for (int r = 0; r < 4; ++r) { float* xr = O + (size_t)(m + r * NGW) * DM + 4 * lane;
            const float rinv = 1.f / sqrtf(wave_sum(s[r]) * (1.f / DM) + 1e-6f);
#pragma unroll
            for (int j = 0; j < 4; ++j) *(f32x4*)(xr + 256 * j) = v[r][j] * rinv * g[j]; }
    }
}

#define XB_TMO      128
#define XB_XCNT(j)  (256  + 64 * (j))
#define XB_XSUB(j)  (1280 + 64 * (j))
#define XB_XGEN(j)  (2304 + 64 * (j))
#define XB_TOP      3328
#define XB_TOPGEN   3392
#define XCD_BAR_WORDS 3456
#define XB_SPIN_CAP (1u << 18)

__device__ __forceinline__ unsigned xb_ld(unsigned* p)              { return __hip_atomic_load(p, __ATOMIC_RELAXED, __HIP_MEMORY_SCOPE_AGENT); }
__device__ __forceinline__ unsigned xb_add(unsigned* p, unsigned v) { return __hip_atomic_fetch_add(p, v, __ATOMIC_RELAXED, __HIP_MEMORY_SCOPE_AGENT); }
__device__ __forceinline__ unsigned xb_xcc_id() { return (unsigned)__builtin_amdgcn_s_getreg((3 << 11) | 20) & 0xFu; }
#define XB_SPIN(cond, bar) do { unsigned _sp = 0; while (cond) { __builtin_amdgcn_s_sleep(1); \
    if ((++_sp & 255u) == 0u) { if (xb_ld(&(bar)[XB_TMO])) break; if (_sp > XB_SPIN_CAP) { atomicAdd(&(bar)[XB_TMO], 1u); break; } } } } while (0)

struct XcdBarrier {
    unsigned* bar; unsigned x; unsigned G;
    volatile LAS unsigned* st;
};

__device__ __forceinline__ XcdBarrier xcd_barrier_post(unsigned* bar, volatile LAS unsigned* st) {
    XcdBarrier b; b.bar = bar; b.x = xb_xcc_id(); b.st = st; b.G = gridDim.x;
    if (threadIdx.x == 0) (void)xb_add(&bar[XB_XCNT(b.x)], 1u);
    return b;
}
__device__ __forceinline__ void xcd_barrier_complete(unsigned* bar, unsigned x, unsigned G, unsigned& nloc, unsigned& nx) {
    unsigned sum, cnt, mine, sp = 0u;
    for (;;) {
        sum = 0u; cnt = 0u; mine = 0u;
#pragma unroll
        for (unsigned j = 0; j < 16; ++j) { const unsigned c = xb_ld(&bar[XB_XCNT(j)]); sum += c; cnt += (c > 0u) ? 1u : 0u; mine = (j == x) ? c : mine; }
        if (sum == G) break;
        __builtin_amdgcn_s_sleep(1);
        if ((++sp & 255u) == 0u) { if (xb_ld(&bar[XB_TMO])) break; if (sp > XB_SPIN_CAP) { atomicAdd(&bar[XB_TMO], 1u); break; } }
    }
    nloc = mine > 0u ? mine : 1u; nx = cnt > 0u ? cnt : 1u;
}

__device__ __forceinline__ void xcd_barrier(const XcdBarrier& b) {
    asm volatile("s_waitcnt vmcnt(0)" ::: "memory");
    __syncthreads();
    if (threadIdx.x == 0) {
        unsigned* bar = b.bar;
        __builtin_amdgcn_s_waitcnt(0);
        unsigned nloc = b.st[0], nx = b.st[1];
        if (nloc == 0u) { xcd_barrier_complete(bar, b.x, b.G, nloc, nx); b.st[0] = nloc; b.st[1] = nx; }
        const unsigned old = xb_add(&bar[XB_XSUB(b.x)], 1u);
        const unsigned gen = old / nloc;
        if (old + 1u == (gen + 1u) * nloc) {
            __builtin_amdgcn_fence(__ATOMIC_RELEASE, "agent");
            asm volatile("s_waitcnt vmcnt(0)" ::: "memory");
            const unsigned og = xb_add(&bar[XB_TOP], 1u);
            const unsigned tg = og / nx;
            if (og + 1u == (tg + 1u) * nx) xb_add(&bar[XB_TOPGEN], 1u);
            else XB_SPIN(xb_ld(&bar[XB_TOPGEN]) == tg, bar);
            __builtin_amdgcn_fence(__ATOMIC_ACQUIRE, "agent");
            xb_add(&bar[XB_XGEN(b.x)], 1u);
            asm volatile("s_waitcnt vmcnt(0)" ::: "memory");
        } else {
            XB_SPIN(xb_ld(&bar[XB_XGEN(b.x)]) == gen, bar);
            __builtin_amdgcn_fence(__ATOMIC_ACQUIRE, "agent");
            asm volatile("s_waitcnt vmcnt(0)" ::: "memory");
        }
    }
    __syncthreads();
}


#ifndef PHM
#define PHM 63
#endif
#define GEMM_PHASE(EPI, AOFF, BOFF, N_, K_, E_) do { pg8::Gemm g_{(const pg8::bf16_t*)(ws + (AOFF)), (const pg8::bf16_t*)(ws + (BOFF)), MTOK, (N_), (K_)}; pg8::StaticOrder S_; S_.init(MTOK, (N_), (int)gridDim.x, (int)blockIdx.x); \
    pg8::gemm_phase<EPI, pg8::StaticOrder, true, true>(lds, g_, S_, (E_)); } while (0)
#define FRESH() KArgs ap = kargs(); unsigned char* ws = ap->ws; (void)ws

__global__ void __launch_bounds__(NTHR, 2) hybrid_fwd(Args a_unused) {
    extern __shared__ __attribute__((aligned(16))) unsigned char lds_raw[];
    LAS unsigned char* lds = (LAS unsigned char*)lds_raw;
    cg::grid_group grid = cg::this_grid();
    volatile LAS unsigned* bst = (volatile LAS unsigned*)(lds + LDS_BYTES - 64);
    if (threadIdx.x < 4) bst[threadIdx.x] = 0u;
    __syncthreads();
    XcdBarrier xbar = xcd_barrier_post((unsigned*)kargs()->ws, bst);
    XcdBarrier xsub = xbar;
    if ((int)blockIdx.x >= 128) { xsub = xcd_barrier_post((unsigned*)kargs()->ws + 4096, bst + 2); xsub.G = gridDim.x - 128; }
    grid.sync();
    const int tid = threadIdx.x, lane = tid & 63, wave = __builtin_amdgcn_readfirstlane(tid >> 6);
    const int gw = blockIdx.x * NWAVES + wave, NGW = gridDim.x * NWAVES;
#pragma unroll 1
    for (int l = 0; l < DEPTH; ++l) {
        { FRESH();
#ifndef NO_PREP
          phase_prep(ap, l, l == 0 ? (const void*)ap->in[0] : (const void*)ap->out, lds, tid, lane, wave);
#endif
        }
        xcd_barrier(xbar);
        if (PHM & 1) { FRESH(); pg8::EpiStore E{(bf16_t*)(ws + WS_PROJ), NPROJ}; GEMM_PHASE(pg8::EpiStore, WS_H, WS_WIN, NPROJ, 1024, E); }
        xcd_barrier(xbar);
#ifndef REPC
#define REPC 1
#endif
#pragma unroll 1
        for (int rep = 0; rep < REPC; ++rep) { FRESH();
          rwkv_act_pass(ap, l, tid); xcd_barrier(xbar);
          if ((int)blockIdx.x < 128) {
#ifndef NO_RWKV
            rwkv_unit(ap, l, blockIdx.x >> 3, blockIdx.x & 7, lds, tid, lane, wave);
#endif
          } else { const int u = blockIdx.x - 128;
#ifndef NO_SSD
#ifndef REPS
#define REPS 1
#endif
#pragma unroll 1
            for (int rs = 0; rs < REPS; ++rs) ssd_unit(ap, l, u >> 3, u & 7, lds, tid, lane, wave);
#endif
#ifndef NO_S5
#pragma unroll 1
            for (int s = u; s < 512; s += 128) s5_unit(ap, l, s >> 5, s & 31, lds, tid, lane, wave);
#endif
            xcd_barrier(xsub);
            { KArgs ap3 = kargs(); ssd_norm_rows(ap3, l, u * NWAVES + wave, 128 * NWAVES, lane); }
            { KArgs ap3 = kargs(); unsigned char* ws3 = ap3->ws;
              pg8::Gemm g_{(const pg8::bf16_t*)(ws3 + WS_ZG), (const pg8::bf16_t*)(ws3 + WS_GLU), MTOK, 512, 512}; pg8::StaticOrder S_; S_.init(MTOK, 512, 128, u);
              pg8::EpiGlu EG{(const bf16_t*)(ws3 + WS_ZG), (bf16_t*)(ws3 + WS_YC), ap3->in[31] + l * 512}; pg8::gemm_phase<pg8::EpiGlu, pg8::StaticOrder, true, true>(lds, g_, S_, EG); }
            { KArgs ap2 = kargs(); unsigned char* ws2 = ap2->ws;
              pg8::Gemm g_{(const pg8::bf16_t*)(ws2 + WS_H), (const pg8::bf16_t*)(ws2 + WS_WG + (size_t)2 * 1024 * 1024 * 2), MTOK, 1024, 1024}; pg8::StaticOrder S_; S_.init(MTOK, 1024, 128, u);
              pg8::EpiSigU8 E8{ws2 + WS_GC8}; pg8::gemm_phase<pg8::EpiSigU8, pg8::StaticOrder, true, true>(lds, g_, S_, E8); }
          } }
        xcd_barrier(xbar);
        if (PHM & 4) {
            { FRESH(); pg8::EpiStore ES{(bf16_t*)(ws + WS_TT), 1024}; GEMM_PHASE(pg8::EpiStore, WS_YA, WS_PA, 1024, 512, ES); }
            { FRESH(); pg8::EpiGate<true> EG{(const bf16_t*)(ws + WS_TT), (bf16_t*)(ws + WS_MERGED)}; GEMM_PHASE(pg8::EpiGate<true>, WS_H, WS_WG, 1024, 1024, EG); }
            { FRESH(); pg8::EpiStore ES{(bf16_t*)(ws + WS_TT), 1024}; GEMM_PHASE(pg8::EpiStore, WS_YB, WS_PB, 1024, 512, ES); }
            { FRESH(); pg8::EpiGate<false> EG{(const bf16_t*)(ws + WS_TT), (bf16_t*)(ws + WS_MERGED)}; GEMM_PHASE(pg8::EpiGate<false>, WS_H, WS_WG + (size_t)1024 * 1024 * 2, 1024, 1024, EG); }
            { FRESH(); pg8::EpiMulAccU8 EM{ws + WS_GC8, (bf16_t*)(ws + WS_MERGED)}; GEMM_PHASE(pg8::EpiMulAccU8, WS_YC, WS_PC, 1024, 512, EM); }
        }
        xcd_barrier(xbar);
        if (PHM & 8) { FRESH();
            if (l == 0) { pg8::EpiResid<false> E{(const void*)ap->in[0], (bf16_t*)ap->out}; GEMM_PHASE(pg8::EpiResid<false>, WS_MERGED, WS_WOUT, 1024, 1024, E); }
            else { pg8::EpiResid<true> E{(const void*)ap->out, (bf16_t*)ap->out}; GEMM_PHASE(pg8::EpiResid<true>, WS_MERGED, WS_WOUT, 1024, 1024, E); } }
        xcd_barrier(xbar);
        { FRESH(); rmsnorm_rows<false, true>((const void*)ap->out, ap->in[34] + l * DM, (bf16_t*)(ws + WS_H), nullptr, nullptr, gw, NGW, lane); }
        xcd_barrier(xbar);
        if (PHM & 16) { FRESH(); pg8::EpiSwiglu E{(bf16_t*)(ws + WS_ACT)}; GEMM_PHASE(pg8::EpiSwiglu, WS_H, WS_FIN, 2 * FFH, 1024, E); }
        xcd_barrier(xbar);
        if (PHM & 32) { FRESH(); pg8::EpiResid<true> E{(const void*)ap->out, l == DEPTH - 1 ? (bf16_t*)(ws + WS_XF) : (bf16_t*)ap->out}; GEMM_PHASE(pg8::EpiResid<true>, WS_ACT, WS_FOUT, 1024, FFH, E); }
        xcd_barrier(xbar);
    }
    { KArgs ap = kargs(); final_norm_rows((const bf16_t*)(ap->ws + WS_XF), ap->out, ap->in[37], gw, NGW, lane); }
}

extern "C" void kernel_launch(void* const* d_in, const int* in_sizes, int n_in, void* d_out, int out_size, void* d_ws, size_t ws_size, hipStream_t stream) {
    static int grid = 0;
    if (grid == 0) {
        if (n_in != 38 || out_size != MTOK * DM || ws_size < WS_END) { fprintf(stderr, "kernel_launch: unexpected problem (n_in %d out %d ws %zu, need %zu)\n", n_in, out_size, ws_size, (size_t)WS_END); grid = -1; return; }
        int dev = 0, cus = 0, per_cu = 0;
        (void)hipGetDevice(&dev); (void)hipDeviceGetAttribute(&cus, hipDeviceAttributeMultiprocessorCount, dev);
        if (hipFuncSetAttribute((const void*)hybrid_fwd, hipFuncAttributeMaxDynamicSharedMemorySize, LDS_BYTES) != hipSuccess) { fprintf(stderr, "kernel_launch: hipFuncSetAttribute failed\n"); grid = -1; return; }
        if (hipOccupancyMaxActiveBlocksPerMultiprocessor(&per_cu, (const void*)hybrid_fwd, NTHR, LDS_BYTES) != hipSuccess || per_cu < 1) { fprintf(stderr, "kernel_launch: occupancy query says %d\n", per_cu); per_cu = 1; }
        (void)hipGetLastError();
        grid = cus;
        if (grid != 256) { fprintf(stderr, "kernel_launch: expected 256 CUs, got %d\n", grid); grid = -1; return; }
    }
    if (grid < 0) return;
    Args a{};
    for (int i = 0; i < 38; ++i) a.in[i] = (const float*)d_in[i];
    a.out = (float*)d_out; a.ws = (unsigned char*)d_ws;
    (void)hipMemsetAsync(d_ws, 0, 32768, stream);
    void* args[] = {&a};
    hipError_t e = hipLaunchCooperativeKernel((const void*)hybrid_fwd, dim3(grid), dim3(NTHR), args, LDS_BYTES, stream);
    if (e != hipSuccess) fprintf(stderr, "cooperative launch failed: %s (grid %d)\n", hipGetErrorString(e), grid);
}
```

```cpp
#include <hip/hip_runtime.h>
#include <hip/hip_cooperative_groups.h>
#include <cstdio>
#include <cstdint>
namespace cg = cooperative_groups;

namespace pg8 {
#define PG8_LAS __attribute__((address_space(3)))
typedef unsigned short bf16_t;
typedef short bf16x8 __attribute__((ext_vector_type(8)));
typedef float f32x4 __attribute__((ext_vector_type(4)));
typedef unsigned u32x4 __attribute__((ext_vector_type(4)));
constexpr int BM = 256, BK = 64, HALF = 128, HTB = HALF * BK * 2  , STAGE_BYTES = 8 * HTB, NXCD = 8, WGM = 4;

__host__ __device__ __forceinline__ int lds_byte(int r, int c) { const int st = (r >> 4) * 2 + (c >> 5), rr = r & 15, cc = c & 31, ob = rr * 64 + cc * 2; return st * 1024 + (ob ^ (((ob >> 9) & 1) << 5)); }
__host__ __device__ __forceinline__ void stage_rc(int b, int& R, int& C) { const int st = b / 1024, sb = b % 1024, swz = sb ^ (((sb >> 9) & 1) << 5); R = (st >> 1) * 16 + swz / 64; C = (st & 1) * 32 + (swz % 64) / 2; }
__host__ __device__ __forceinline__ int perm32(int rho) { const int n = rho >> 4, i = rho & 15; return 8 * (i >> 2) + 4 * n + (i & 3); }

struct Unit { int pm, pn; };
struct Gemm { const bf16_t* A; const bf16_t* Bt; int M, N, K; };

struct StaticOrder {
    int nM, nN, nwg, G, c;
    __host__ __device__ void init(int M, int N, int G_, int c_) { nM = M / BM; nN = N / BM; nwg = nM * nN; G = G_; c = c_; }
    __host__ __device__ bool next(int i, Unit& u) const {
        const long L = (long)i * G + c; if (L >= nwg) return false;
        int wgid = (int)L; { const int q = nwg / NXCD, r = nwg % NXCD, xcd = wgid % NXCD, off = wgid / NXCD; wgid = (xcd < r ? xcd * (q + 1) : r * (q + 1) + (xcd - r) * q) + off; }
        const int nig = WGM * nN, gid = wgid / nig, fm = gid * WGM, gsz = (nM - fm) < WGM ? (nM - fm) : WGM;
        u.pm = fm + ((wgid % nig) % gsz); u.pn = (wgid % nig) / gsz; return true;
    }
    __device__ __forceinline__ void a_ready(const Unit&) const {}
    __device__ __forceinline__ void done(const Unit&) const {}
};

template <class Epi, class Sched, bool ALIGN_EPI = false, bool SP2 = false>
__device__ __forceinline__ void gemm_phase(PG8_LAS unsigned char* lds, const Gemm g, const Sched& S, const Epi& E) {
    int tid_ = threadIdx.x; asm volatile("" : "+v"(tid_));
    const int tid = tid_, wid = __builtin_amdgcn_readfirstlane(tid >> 6), lane = tid & 63, wr = wid >> 2, wc = wid & 3, fr = lane & 15, fq = lane >> 4;
    const int K = g.K, nt = K / BK;
    unsigned voffA[2], voffB[2];
#pragma unroll
    for (int i = 0; i < 2; ++i) { int R, C; stage_rc(tid * 16 + i * 8192, R, C); const int Rb = Epi::PERM ? ((R & ~31) + perm32(R & 31)) : R;
        voffA[i] = (unsigned)(R * K + C) * 2u; voffB[i] = (unsigned)(Rb * K + C) * 2u; }
    const size_t kstep = (size_t)(BK * 2);
    const size_t hstep = (size_t)HALF * K * 2;
    const size_t tstep = 2 * hstep;
    const unsigned ldsw = (unsigned)wid * 1024u;
    const int aoff = lds_byte(wr * 64 + fr, fq * 8), boff = lds_byte(wc * 32 + fr, fq * 8);
#define PG8_SA(b, h) (((b) * 2 + (h)) * HTB)
#define PG8_SB(b, h) ((4 + (b) * 2 + (h)) * HTB)
#define PG8_STAGE(bufoff, gbase, voff) do { _Pragma("unroll") for (int _i = 0; _i < 2; ++_i) \
        __builtin_amdgcn_global_load_lds((const unsigned*)((const char*)(gbase) + (voff)[_i]), (PG8_LAS unsigned*)(lds + (bufoff) + ldsw + _i * 8192), 16, 0, 0); } while (0)
#define PG8_LDA(dst, b, h) do { _Pragma("unroll") for (int m = 0; m < 4; ++m) _Pragma("unroll") for (int k = 0; k < 2; ++k) dst[m][k] = *(const PG8_LAS bf16x8*)(lds + PG8_SA(b, h) + aoff + m * 2048 + k * 1024); } while (0)
#define PG8_LDB(dst, b, h) do { _Pragma("unroll") for (int n = 0; n < 2; ++n) _Pragma("unroll") for (int k = 0; k < 2; ++k) dst[n][k] = *(const PG8_LAS bf16x8*)(lds + PG8_SB(b, h) + boff + n * 2048 + k * 1024); } while (0)
#define PG8_MMA(ai, bj, At, Bt) do { __builtin_amdgcn_s_setprio(1); _Pragma("unroll") for (int m = 0; m < 4; ++m) _Pragma("unroll") for (int n = 0; n < 2; ++n) _Pragma("unroll") for (int k = 0; k < 2; ++k) \
        acc[ai][bj][m][n] = __builtin_amdgcn_mfma_f32_16x16x32_bf16(Bt[n][k], At[m][k], acc[ai][bj][m][n], 0, 0, 0); __builtin_amdgcn_s_setprio(0); } while (0)
#define PG8_WAIT_V(n) asm volatile("s_waitcnt vmcnt(" #n ")" ::: "memory")
#define PG8_WAIT_L(n) asm volatile("s_waitcnt lgkmcnt(" #n ")" ::: "memory")
#define PG8_BAR __builtin_amdgcn_s_barrier()
#define PG8_SCHED __builtin_amdgcn_sched_barrier(0)
    Unit cur, nxt; int ui = 0;
    if (!S.next(0, cur)) return;
    f32x4 acc[2][2][4][2];
#pragma unroll
    for (int a = 0; a < 2; ++a)
#pragma unroll
        for (int b = 0; b < 2; ++b)
#pragma unroll
            for (int m = 0; m < 4; ++m)
#pragma unroll
                for (int n = 0; n < 2; ++n) acc[a][b][m][n] = (f32x4){0.f, 0.f, 0.f, 0.f};
    bf16x8 At[4][2], B0[2][2], B1[2][2];
    const char* cA = (const char*)g.A + (size_t)cur.pm * tstep; const char* cB = (const char*)g.Bt + (size_t)cur.pn * tstep;
    S.a_ready(cur);
    if constexpr (SP2) {
        PG8_STAGE(PG8_SB(0, 0), cB, voffB); PG8_STAGE(PG8_SB(0, 1), cB + hstep, voffB); PG8_STAGE(PG8_SA(0, 0), cA, voffA); PG8_STAGE(PG8_SA(0, 1), cA + hstep, voffA);
        if (wr == 1) PG8_BAR;
        PG8_WAIT_V(2); PG8_BAR;
        PG8_STAGE(PG8_SB(1, 0), cB + kstep, voffB); PG8_STAGE(PG8_SA(1, 0), cA + kstep, voffA); PG8_STAGE(PG8_SB(1, 1), cB + hstep + kstep, voffB);
        PG8_WAIT_V(6); PG8_BAR;
    } else {
        PG8_STAGE(PG8_SB(0, 0), cB, voffB); PG8_STAGE(PG8_SA(0, 0), cA, voffA); PG8_STAGE(PG8_SB(0, 1), cB + hstep, voffB); PG8_STAGE(PG8_SA(0, 1), cA + hstep, voffA);
        if (wr == 1) PG8_BAR;
        PG8_WAIT_V(4); PG8_BAR;
        PG8_STAGE(PG8_SB(1, 0), cB + kstep, voffB); PG8_STAGE(PG8_SA(1, 0), cA + kstep, voffA); PG8_STAGE(PG8_SB(1, 1), cB + hstep + kstep, voffB);
        PG8_WAIT_V(6); PG8_BAR;
    }
    for (;;) {
        const bool has_next = S.next(ui + 1, nxt);
        const char* nA = has_next ? (const char*)g.A + (size_t)nxt.pm * tstep : cA; const char* nB = has_next ? (const char*)g.Bt + (size_t)nxt.pn * tstep : cB;
        for (int t = 0; t < nt; t += 2) {
            const bool last = (t == nt - 2);
            const char* a1 = cA + (size_t)(t + 1) * kstep;
            const char* a2 = last ? nA : cA + (size_t)(t + 2) * kstep; const char* b2 = last ? nB : cB + (size_t)(t + 2) * kstep;
            const char* a3 = a2 + kstep; const char* b3 = b2 + kstep;
            if (last && has_next) S.a_ready(nxt);
            if constexpr (SP2) {
            PG8_LDB(B0, 0, 0); PG8_LDB(B1, 0, 1); PG8_SCHED; PG8_LDA(At, 0, 0); PG8_STAGE(PG8_SA(1, 1), a1 + hstep, voffA);
            PG8_WAIT_V(8); PG8_WAIT_L(0); PG8_BAR; PG8_MMA(0, 0, At, B0); PG8_MMA(0, 1, At, B1); PG8_BAR; PG8_SCHED;
            PG8_LDA(At, 0, 1); PG8_STAGE(PG8_SB(0, 0), b2, voffB); PG8_STAGE(PG8_SB(0, 1), b2 + hstep, voffB); PG8_STAGE(PG8_SA(0, 0), a2, voffA);
            PG8_WAIT_V(8); PG8_WAIT_L(0); PG8_BAR; PG8_MMA(1, 0, At, B0); PG8_MMA(1, 1, At, B1); PG8_BAR; PG8_SCHED;
            PG8_LDB(B0, 1, 0); PG8_LDB(B1, 1, 1); PG8_SCHED; PG8_LDA(At, 1, 0); PG8_STAGE(PG8_SA(0, 1), a2 + hstep, voffA);
            PG8_WAIT_V(8); PG8_WAIT_L(0); PG8_BAR; PG8_MMA(0, 0, At, B0); PG8_MMA(0, 1, At, B1); PG8_BAR; PG8_SCHED;
            PG8_LDA(At, 1, 1); PG8_STAGE(PG8_SB(1, 0), b3, voffB); PG8_STAGE(PG8_SB(1, 1), b3 + hstep, voffB); PG8_STAGE(PG8_SA(1, 0), a3, voffA);
            PG8_WAIT_V(8); PG8_WAIT_L(0); PG8_BAR; PG8_MMA(1, 0, At, B0); PG8_MMA(1, 1, At, B1); PG8_BAR; PG8_SCHED;
            } else {
            PG8_LDB(B0, 0, 0); PG8_SCHED; PG8_LDA(At, 0, 0); PG8_STAGE(PG8_SA(1, 1), a1 + hstep, voffA);
            PG8_WAIT_L(8); PG8_BAR; PG8_WAIT_L(0); PG8_MMA(0, 0, At, B0); PG8_BAR; PG8_SCHED;
            PG8_LDB(B1, 0, 1); PG8_STAGE(PG8_SB(0, 0), b2, voffB);
            PG8_BAR; PG8_WAIT_L(0); PG8_MMA(0, 1, At, B1); PG8_BAR;
            PG8_LDA(At, 0, 1); PG8_STAGE(PG8_SA(0, 0), a2, voffA);
            PG8_BAR; PG8_WAIT_L(0); PG8_MMA(1, 0, At, B0); PG8_BAR; PG8_SCHED;
            PG8_STAGE(PG8_SB(0, 1), b2 + hstep, voffB);
            PG8_WAIT_V(6); PG8_BAR; PG8_MMA(1, 1, At, B1); PG8_BAR;
            PG8_LDB(B0, 1, 0); PG8_SCHED; PG8_LDA(At, 1, 0); PG8_STAGE(PG8_SA(0, 1), a2 + hstep, voffA);
            PG8_WAIT_L(8); PG8_BAR; PG8_WAIT_L(0); PG8_MMA(0, 0, At, B0); PG8_BAR; PG8_SCHED;
            PG8_LDB(B1, 1, 1); PG8_STAGE(PG8_SB(1, 0), b3, voffB);
            PG8_BAR; PG8_WAIT_L(0); PG8_MMA(0, 1, At, B1); PG8_BAR;
            PG8_LDA(At, 1, 1); PG8_STAGE(PG8_SA(1, 0), a3, voffA);
            PG8_BAR; PG8_WAIT_L(0); PG8_MMA(1, 0, At, B0); PG8_BAR; PG8_SCHED;
            PG8_STAGE(PG8_SB(1, 1), b3 + hstep, voffB);
            PG8_WAIT_V(6); PG8_BAR; PG8_MMA(1, 1, At, B1); PG8_BAR;
            }
        }
        if constexpr (ALIGN_EPI) { if (wr == 0) PG8_BAR; }
        if constexpr (!Epi::AFTER_DRAIN) { E(acc, cur, wr, wc, fr, fq); S.done(cur); }
        if (!has_next) break;
#pragma unroll
        for (int a = 0; a < 2; ++a)
#pragma unroll
            for (int b = 0; b < 2; ++b)
#pragma unroll
                for (int m = 0; m < 4; ++m)
#pragma unroll
                    for (int n = 0; n < 2; ++n) acc[a][b][m][n] = (f32x4){0.f, 0.f, 0.f, 0.f};
        cur = nxt; cA = nA; cB = nB; ++ui;
        if constexpr (ALIGN_EPI) { if (wr == 1) PG8_BAR; }
    }
    PG8_WAIT_V(0);
    if constexpr (!ALIGN_EPI) { if (wr == 0) PG8_BAR; }
    PG8_BAR;
    if constexpr (Epi::AFTER_DRAIN) { E.fused(acc, cur, wr, wc, fr, fq, lds, wid, lane); S.done(cur); }
#undef PG8_SA
#undef PG8_SB
#undef PG8_STAGE
#undef PG8_LDA
#undef PG8_LDB
#undef PG8_MMA
#undef PG8_WAIT_V
#undef PG8_WAIT_L
#undef PG8_BAR
#undef PG8_SCHED
}
}

#ifndef PG8_SP2
#define PG8_SP2 true
#endif
#ifndef PG8_ALIGN
#define PG8_ALIGN true
#endif

#define LAS __attribute__((address_space(3)))
typedef unsigned short bf16_t;
typedef short bf16x8 __attribute__((ext_vector_type(8)));
typedef float f32x4 __attribute__((ext_vector_type(4)));
typedef float f32x2 __attribute__((ext_vector_type(2)));
typedef unsigned u32x4 __attribute__((ext_vector_type(4)));
typedef unsigned u32x2 __attribute__((ext_vector_type(2)));

__device__ __forceinline__ unsigned f2bf(float f) { unsigned u = __builtin_bit_cast(unsigned, f); return (u + 0x7fffu + ((u >> 16) & 1u)) >> 16; }
__device__ __forceinline__ unsigned pk2(float lo, float hi) { unsigned r; asm volatile("v_cvt_pk_bf16_f32 %0, %1, %2" : "=v"(r) : "v"(lo), "v"(hi)); return r; }
__device__ __forceinline__ float bf_lo(unsigned w) { return __builtin_bit_cast(float, w << 16); }
__device__ __forceinline__ float bf_hi(unsigned w) { return __builtin_bit_cast(float, w & 0xffff0000u); }
__device__ __forceinline__ float bf2f(bf16_t b) { return __builtin_bit_cast(float, (unsigned)b << 16); }
__device__ __forceinline__ void unpack8(u32x4 v, float* o) { o[0] = bf_lo(v.x); o[1] = bf_hi(v.x); o[2] = bf_lo(v.y); o[3] = bf_hi(v.y); o[4] = bf_lo(v.z); o[5] = bf_hi(v.z); o[6] = bf_lo(v.w); o[7] = bf_hi(v.w); }
__device__ __forceinline__ u32x4 pack8(const float* o) { u32x4 v; v.x = pk2(o[0], o[1]); v.y = pk2(o[2], o[3]); v.z = pk2(o[4], o[5]); v.w = pk2(o[6], o[7]); return v; }
__device__ __forceinline__ float sigm(float x) { return __builtin_amdgcn_rcpf(1.f + __expf(-x)); }
__device__ __forceinline__ float ftanh(float x) { return 1.f - 2.f * __builtin_amdgcn_rcpf(1.f + __expf(2.f * x)); }
__device__ __forceinline__ float softplusf(float z) { return z > 20.f ? z : log1pf(expf(z)); }
template <int CTRL> __device__ __forceinline__ float dppf(float x) { return __builtin_bit_cast(float, __builtin_amdgcn_update_dpp(0, __builtin_bit_cast(int, x), CTRL, 0xf, 0xf, true)); }
__device__ __forceinline__ float red8(float x) { x += dppf<0xB1>(x); x += dppf<0x4E>(x); x += dppf<0x141>(x); return x; }
__device__ __forceinline__ float red16(float x) { x = red8(x); x += dppf<0x140>(x); return x; }
__device__ __forceinline__ float red32(float x) { x = red16(x); x += __shfl_xor(x, 16); return x; }
__device__ __forceinline__ float wave_sum(float x) { x = red32(x); x += __shfl_xor(x, 32); return x; }
__device__ __forceinline__ bf16x8 ldsfrag(const LAS bf16_t* base, int row, int stride, int k) { return *(const LAS bf16x8*)(base + row * stride + k); }
#define MFMA16(a, b, c) __builtin_amdgcn_mfma_f32_16x16x32_bf16((a), (b), (c), 0, 0, 0)

namespace pg8 {
struct EpiStore {
    static constexpr bool PERM = true, AFTER_DRAIN = false;
    bf16_t* O; int ldc;
    __device__ __forceinline__ void operator()(const f32x4 (&acc)[2][2][4][2], const Unit& u, int wr, int wc, int fr, int fq) const {
        const int row0 = u.pm * BM + wr * 64 + fr, col0 = u.pn * BM + wc * 32 + 8 * fq;
#pragma unroll
        for (int ai = 0; ai < 2; ++ai)
#pragma unroll
            for (int m = 0; m < 4; ++m) { bf16_t* rowp = O + (size_t)(row0 + ai * HALF + m * 16) * ldc + col0;
#pragma unroll
                for (int bj = 0; bj < 2; ++bj) { const f32x4 v0 = acc[ai][bj][m][0], v1 = acc[ai][bj][m][1];
                    u32x4 w; w.x = pk2(v0[0], v0[1]); w.y = pk2(v0[2], v0[3]); w.z = pk2(v1[0], v1[1]); w.w = pk2(v1[2], v1[3]);
                    *(u32x4*)(rowp + bj * HALF) = w; } }
    }
};
template <bool FIRST> struct EpiGate {
    static constexpr bool PERM = true, AFTER_DRAIN = false;
    const bf16_t* T; bf16_t* Mg;
    __device__ __forceinline__ void operator()(const f32x4 (&acc)[2][2][4][2], const Unit& u, int wr, int wc, int fr, int fq) const {
        const int row0 = u.pm * BM + wr * 64 + fr, col0 = u.pn * BM + wc * 32 + 8 * fq;
#pragma unroll
        for (int ai = 0; ai < 2; ++ai) {
            u32x4 tb[4][2], pb[4][2];
#pragma unroll
            for (int m = 0; m < 4; ++m)
#pragma unroll
                for (int bj = 0; bj < 2; ++bj) { const size_t ro = (size_t)(row0 + ai * HALF + m * 16) * 1024 + col0 + bj * HALF;
                    tb[m][bj] = *(const u32x4*)(T + ro); if (!FIRST) pb[m][bj] = *(const u32x4*)(Mg + ro); }
            asm volatile("" ::: "memory");
#pragma unroll
            for (int m = 0; m < 4; ++m)
#pragma unroll
                for (int bj = 0; bj < 2; ++bj) { const size_t ro = (size_t)(row0 + ai * HALF + m * 16) * 1024 + col0 + bj * HALF;
                    const f32x4 v0 = acc[ai][bj][m][0], v1 = acc[ai][bj][m][1];
                    float t[8], r[8]; unpack8(tb[m][bj], t);
                    r[0] = sigm(v0[0]) * t[0]; r[1] = sigm(v0[1]) * t[1]; r[2] = sigm(v0[2]) * t[2]; r[3] = sigm(v0[3]) * t[3];
                    r[4] = sigm(v1[0]) * t[4]; r[5] = sigm(v1[1]) * t[5]; r[6] = sigm(v1[2]) * t[6]; r[7] = sigm(v1[3]) * t[7];
                    if (!FIRST) { float p[8]; unpack8(pb[m][bj], p);
#pragma unroll
                        for (int e = 0; e < 8; ++e) r[e] += p[e]; }
                    *(u32x4*)(Mg + ro) = pack8(r); }
        }
    }
};
template <bool BASE_BF> struct EpiResid {
    static constexpr bool PERM = true, AFTER_DRAIN = false;
    const void* base; bf16_t* out;
    __device__ __forceinline__ void operator()(const f32x4 (&acc)[2][2][4][2], const Unit& u, int wr, int wc, int fr, int fq) const {
        const int row0 = u.pm * BM + wr * 64 + fr, col0 = u.pn * BM + wc * 32 + 8 * fq;
#pragma unroll
        for (int ai = 0; ai < 2; ++ai) {
            f32x4 bb[4][2][2]; u32x4 bh[4][2];
#pragma unroll
            for (int m = 0; m < 4; ++m)
#pragma unroll
                for (int bj = 0; bj < 2; ++bj) { const size_t ro = (size_t)(row0 + ai * HALF + m * 16) * 1024 + col0 + bj * HALF;
                    if (BASE_BF) bh[m][bj] = *(const u32x4*)((const bf16_t*)base + ro);
                    else { bb[m][bj][0] = *(const f32x4*)((const float*)base + ro); bb[m][bj][1] = *(const f32x4*)((const float*)base + ro + 4); } }
            asm volatile("" ::: "memory");
#pragma unroll
            for (int m = 0; m < 4; ++m)
#pragma unroll
                for (int bj = 0; bj < 2; ++bj) { const size_t ro = (size_t)(row0 + ai * HALF + m * 16) * 1024 + col0 + bj * HALF;
                    float b[8];
                    if (BASE_BF) unpack8(bh[m][bj], b);
                    else { b[0] = bb[m][bj][0].x; b[1] = bb[m][bj][0].y; b[2] = bb[m][bj][0].z; b[3] = bb[m][bj][0].w; b[4] = bb[m][bj][1].x; b[5] = bb[m][bj][1].y; b[6] = bb[m][bj][1].z; b[7] = bb[m][bj][1].w; }
                    const f32x4 v0 = acc[ai][bj][m][0], v1 = acc[ai][bj][m][1];
                    b[0] += v0[0]; b[1] += v0[1]; b[2] += v0[2]; b[3] += v0[3]; b[4] += v1[0]; b[5] += v1[1]; b[6] += v1[2]; b[7] += v1[3];
                    *(u32x4*)(out + ro) = pack8(b); }
        }
    }
};
struct EpiSwiglu {
    static constexpr bool PERM = true, AFTER_DRAIN = false;
    bf16_t* O;
    __device__ __forceinline__ void operator()(const f32x4 (&acc)[2][2][4][2], const Unit& u, int wr, int wc, int fr, int fq) const {
        const int row0 = u.pm * BM + wr * 64 + fr, col0 = u.pn * HALF + wc * 32 + 8 * fq;
#pragma unroll
        for (int ai = 0; ai < 2; ++ai)
#pragma unroll
            for (int m = 0; m < 4; ++m) { bf16_t* p = O + (size_t)(row0 + ai * HALF + m * 16) * 2816 + col0;
                float r[8];
#pragma unroll
                for (int n = 0; n < 2; ++n)
#pragma unroll
                    for (int e = 0; e < 4; ++e) { const float g = acc[ai][0][m][n][e], up = acc[ai][1][m][n][e]; r[4 * n + e] = g * sigm(g) * up; }
                *(u32x4*)p = pack8(r); }
    }
};
struct EpiSigU8 {
    static constexpr bool PERM = true, AFTER_DRAIN = false;
    unsigned char* O;
    __device__ __forceinline__ void operator()(const f32x4 (&acc)[2][2][4][2], const Unit& u, int wr, int wc, int fr, int fq) const {
        const int row0 = u.pm * BM + wr * 64 + fr, col0 = u.pn * BM + wc * 32 + 8 * fq;
#pragma unroll
        for (int ai = 0; ai < 2; ++ai)
#pragma unroll
            for (int m = 0; m < 4; ++m)
#pragma unroll
                for (int bj = 0; bj < 2; ++bj) { const f32x4 v0 = acc[ai][bj][m][0], v1 = acc[ai][bj][m][1];
                    unsigned q[8];
#pragma unroll
                    for (int e = 0; e < 4; ++e) { q[e] = (unsigned)(sigm(v0[e]) * 255.f + 0.5f); q[4 + e] = (unsigned)(sigm(v1[e]) * 255.f + 0.5f); }
                    u32x2 w; w.x = q[0] | (q[1] << 8) | (q[2] << 16) | (q[3] << 24); w.y = q[4] | (q[5] << 8) | (q[6] << 16) | (q[7] << 24);
                    *(u32x2*)(O + (size_t)(row0 + ai * HALF + m * 16) * 1024 + col0 + bj * HALF) = w; }
    }
};
struct EpiMulAccU8 {
    static constexpr bool PERM = true, AFTER_DRAIN = false;
    const unsigned char* G; bf16_t* Mg;
    __device__ __forceinline__ void operator()(const f32x4 (&acc)[2][2][4][2], const Unit& u, int wr, int wc, int fr, int fq) const {
        const int row0 = u.pm * BM + wr * 64 + fr, col0 = u.pn * BM + wc * 32 + 8 * fq;
#pragma unroll
        for (int ai = 0; ai < 2; ++ai) {
            u32x2 gb[4][2]; u32x4 pb[4][2];
#pragma unroll
            for (int m = 0; m < 4; ++m)
#pragma unroll
                for (int bj = 0; bj < 2; ++bj) { const size_t ro = (size_t)(row0 + ai * HALF + m * 16) * 1024 + col0 + bj * HALF;
                    gb[m][bj] = *(const u32x2*)(G + ro); pb[m][bj] = *(const u32x4*)(Mg + ro); }
            asm volatile("" ::: "memory");
#pragma unroll
            for (int m = 0; m < 4; ++m)
#pragma unroll
                for (int bj = 0; bj < 2; ++bj) { const size_t ro = (size_t)(row0 + ai * HALF + m * 16) * 1024 + col0 + bj * HALF;
                    const f32x4 v0 = acc[ai][bj][m][0], v1 = acc[ai][bj][m][1];
                    float p[8], r[8]; unpack8(pb[m][bj], p);
                    const unsigned ga = gb[m][bj].x, gc = gb[m][bj].y; const float k = 1.f / 255.f;
                    r[0] = p[0] + (float)(ga & 255u) * k * v0[0]; r[1] = p[1] + (float)((ga >> 8) & 255u) * k * v0[1]; r[2] = p[2] + (float)((ga >> 16) & 255u) * k * v0[2]; r[3] = p[3] + (float)(ga >> 24) * k * v0[3];
                    r[4] = p[4] + (float)(gc & 255u) * k * v1[0]; r[5] = p[5] + (float)((gc >> 8) & 255u) * k * v1[1]; r[6] = p[6] + (float)((gc >> 16) & 255u) * k * v1[2]; r[7] = p[7] + (float)(gc >> 24) * k * v1[3];
                    *(u32x4*)(Mg + ro) = pack8(r); }
        }
    }
};
struct EpiGlu {
    static constexpr bool PERM = true, AFTER_DRAIN = false;
    const bf16_t* Z; bf16_t* O; const float* bias;
    __device__ __forceinline__ void operator()(const f32x4 (&acc)[2][2][4][2], const Unit& u, int wr, int wc, int fr, int fq) const {
        const int row0 = u.pm * BM + wr * 64 + fr, col0 = u.pn * BM + wc * 32 + 8 * fq;
        f32x4 bv[2][2];
#pragma unroll
        for (int bj = 0; bj < 2; ++bj) { bv[bj][0] = *(const f32x4*)(bias + col0 + bj * HALF); bv[bj][1] = *(const f32x4*)(bias + col0 + bj * HALF + 4); }
#pragma unroll
        for (int ai = 0; ai < 2; ++ai) {
            u32x4 zb[4][2];
#pragma unroll
            for (int m = 0; m < 4; ++m)
#pragma unroll
                for (int bj = 0; bj < 2; ++bj) zb[m][bj] = *(const u32x4*)(Z + (size_t)(row0 + ai * HALF + m * 16) * 512 + col0 + bj * HALF);
            asm volatile("" ::: "memory");
#pragma unroll
            for (int m = 0; m < 4; ++m)
#pragma unroll
                for (int bj = 0; bj < 2; ++bj) { const f32x4 v0 = acc[ai][bj][m][0], v1 = acc[ai][bj][m][1];
                    float z[8], r[8]; unpack8(zb[m][bj], z);
#pragma unroll
                    for (int e = 0; e < 4; ++e) { r[e] = z[e] * sigm(v0[e] + bv[bj][0][e]); r[4 + e] = z[4 + e] * sigm(v1[e] + bv[bj][1][e]); }
                    *(u32x4*)(O + (size_t)(row0 + ai * HALF + m * 16) * 512 + col0 + bj * HALF) = pack8(r); }
        }
    }
};
}

constexpr int DM = 1024, BATCH = 16, SEQ = 2048, MTOK = BATCH * SEQ, DEPTH = 2;
constexpr int IN_COLS = 6920, NPROJ = 3840, FFH = 2816;
constexpr int P_R = 0, P_K = 512, P_V = 1024, P_WD = 1536, P_AD = 1600, P_GD = 1664, P_Z = 1792, P_XS = 2304, P_B = 2816, P_C = 3072, P_U = 3328;
constexpr int NWAVES = 8, NTHR = 512;
constexpr size_t MiB = 1u << 20, KiB = 1u << 10;
constexpr size_t WS_WIN = 1 * MiB, WS_WG = 9 * MiB, WS_PA = 15 * MiB, WS_PB = 16 * MiB, WS_PC = 17 * MiB, WS_GLU = 18 * MiB, WS_WOUT = 19 * MiB,
                 WS_FIN = 21 * MiB, WS_FOUT = 32 * MiB, WS_WUP = 38 * MiB, WS_AUP = 38 * MiB + 64 * KiB, WS_GUP = 38 * MiB + 128 * KiB, WS_A16 = 38 * MiB + 256 * KiB,
                 WS_TM = 39 * MiB, WS_M3 = 45 * MiB, WS_DT = 47 * MiB, WS_H = 48 * MiB, WS_YA = 112 * MiB, WS_YB = 144 * MiB, WS_YC = 176 * MiB, WS_ZG = 208 * MiB,
                 WS_PROJ = 240 * MiB, WS_GC8 = 480 * MiB  , WS_END = 512 * MiB;
constexpr size_t WS_XF = 416 * MiB;
constexpr size_t WS_MERGED = WS_PROJ, WS_TT = WS_PROJ + 64 * MiB, WS_ACT = WS_PROJ;
constexpr int LDS_BYTES = 151552;

struct Args { const float* in[38]; float* out; unsigned char* ws; };
typedef const __attribute__((address_space(4))) Args* KArgs;
typedef const __attribute__((address_space(4))) Args& KArgsRef;
__device__ __forceinline__ KArgs kargs() { KArgs p = (KArgs)__builtin_amdgcn_kernarg_segment_ptr(); asm volatile("" : "+s"(p)); return p; }
__device__ __forceinline__ int opq(int x) { asm volatile("" : "+v"(x)); return x; }

__device__ __forceinline__ void tr_item(const float* __restrict__ W, int ldw, int k0, int c0, bf16_t* __restrict__ WT, int K, int n0, LAS float* scr, int lane) {
    float wv_[32];
#pragma unroll
    for (int i = 0; i < 32; ++i) { const int kk = 2 * i + (lane >> 5); wv_[i] = W[(size_t)(k0 + kk) * ldw + c0 + (lane & 31)]; }
#pragma unroll
    for (int i = 0; i < 32; ++i) { const int kk = 2 * i + (lane >> 5); scr[kk * 33 + (lane & 31)] = wv_[i]; }
    asm volatile("s_waitcnt lgkmcnt(0)" ::: "memory");
    const int c = lane & 7;
#pragma unroll
    for (int j = 0; j < 4; ++j) { const int n = (lane >> 3) + 8 * j; const LAS float* s = scr + (8 * c) * 33 + n;
        u32x4 o; o.x = pk2(s[0 * 33], s[1 * 33]); o.y = pk2(s[2 * 33], s[3 * 33]); o.z = pk2(s[4 * 33], s[5 * 33]); o.w = pk2(s[6 * 33], s[7 * 33]);
        *(u32x4*)(WT + (size_t)(n0 + n) * K + k0 + 8 * c) = o; }
    asm volatile("s_waitcnt lgkmcnt(0)" ::: "memory");
}

__device__ __forceinline__ void s5_prep(KArgs ap_, int l, int g, int q, LAS unsigned char* lds, int tid) {
    KArgs ap = ap_; asm volatile("" : "+s"(ap)); KArgsRef a = *ap; tid = opq(tid);
    LAS float* AR = (LAS float*)lds;
    LAS float* AI = AR + 17 * 64;
    LAS float* BBR = AI + 17 * 64;
    LAS float* BBI = BBR + 1024;
    LAS float* CR = BBI + 1024;
    LAS float* CI = CR + 1024;
    LAS float* KT = CI + 1024;
    unsigned char* ws = a.ws;
    bf16_t* TM = (bf16_t*)(ws + WS_TM) + (size_t)g * 384 * 256;
    bf16_t* M3 = (bf16_t*)(ws + WS_M3) + (size_t)g * 256 * 128;
    float* A16 = (float*)(ws + WS_A16) + g * 128;
    const float* dsk = a.in[29] + l * 512 + 16 * g;
    const float step = expf(a.in[24][l * 32 + g]);
    const float* lre = a.in[22] + (size_t)(l * 32 + g) * 64; const float* lim = a.in[23] + (size_t)(l * 32 + g) * 64;
    for (int e = tid; e < 17 * 64; e += NTHR) { const int t = e >> 6, n = e & 63; const float lr = lre[n], li = lim[n];
        const float mag = expf(lr * step * (float)t), ang = li * step * (float)t; AR[e] = mag * cosf(ang); AI[e] = mag * sinf(ang); }
    for (int e = tid; e < 1024; e += NTHR) { CR[e] = a.in[27][(size_t)(l * 32 + g) * 1024 + e]; CI[e] = a.in[28][(size_t)(l * 32 + g) * 1024 + e]; }
    __syncthreads();
    for (int e = tid; e < 1024; e += NTHR) { const int n = e >> 4, i = e & 15; const float lr = lre[n], li = lim[n];
        const float abr = AR[64 + n], abi = AI[64 + n], den = lr * lr + li * li;
        const float cre = ((abr - 1.f) * lr + abi * li) / den, cim = (abi * lr - (abr - 1.f) * li) / den;
        const float br = a.in[25][((size_t)(l * 32 + g) * 64 + n) * 16 + i], bi = a.in[26][((size_t)(l * 32 + g) * 64 + n) * 16 + i];
        BBR[e] = cre * br - cim * bi; BBI[e] = cre * bi + cim * br; }
    if (q == 0 && tid < 64) { A16[2 * tid] = AR[16 * 64 + tid]; A16[2 * tid + 1] = AI[16 * 64 + tid]; }
    __syncthreads();
    for (int e2 = tid; e2 < 1024; e2 += NTHR) { const int e = 1024 * q + e2; const int t = e >> 8, o = (e >> 4) & 15, i = e & 15; float s = 0.f;
        for (int n = 0; n < 64; ++n) { const float cr = CR[o * 64 + n], ci = CI[o * 64 + n], pr = AR[t * 64 + n], pi = AI[t * 64 + n];
            const float xr = cr * pr - ci * pi, xi = cr * pi + ci * pr; s += xr * BBR[n * 16 + i] - xi * BBI[n * 16 + i]; }
        if (t == 0 && o == i) s += dsk[o];
        KT[e] = s; }
    __syncthreads();
    for (int e = tid; e < 256 * 128; e += NTHR) { const int nn = e >> 7, kk = 2 * (e & 127), t = nn >> 4, o = nn & 15, j = kk >> 4, i = kk & 15, d = t - j;
        if (d >= 0 ? (d >> 2) == q : q == 0) { float v0 = 0.f, v1 = 0.f; if (d >= 0) { v0 = KT[(d * 16 + o) * 16 + i]; v1 = KT[(d * 16 + o) * 16 + i + 1]; }
            *(unsigned*)(TM + (size_t)nn * 256 + kk) = pk2(v0, v1); } }
    for (int e = tid; e < 32 * 128; e += NTHR) { const int rr = 32 * q + (e >> 7), kk = 2 * (e & 127), n = rr >> 1, ri = rr & 1, j = kk >> 4, i = kk & 15;
        const float pr = AR[(15 - j) * 64 + n], pi = AI[(15 - j) * 64 + n];
        float v[2];
#pragma unroll
        for (int qq = 0; qq < 2; ++qq) { const float br = BBR[n * 16 + i + qq], bi = BBI[n * 16 + i + qq]; v[qq] = ri == 0 ? pr * br - pi * bi : pr * bi + pi * br; }
        *(unsigned*)(TM + (size_t)(256 + rr) * 256 + kk) = pk2(v[0], v[1]); }
    for (int e = tid; e < 64 * 64; e += NTHR) { const int nn = 64 * q + (e >> 6), n = e & 63, t = nn >> 4, o = nn & 15;
        const float cr = CR[o * 64 + n], ci = CI[o * 64 + n], pr = AR[(t + 1) * 64 + n], pi = AI[(t + 1) * 64 + n];
        *(unsigned*)(M3 + (size_t)nn * 128 + 2 * n) = pk2(cr * pr - ci * pi, -(cr * pi + ci * pr)); }
    __syncthreads();
}

template <bool WITH_DT, bool IN_BF> __device__ __forceinline__ void rmsnorm_rows(const void* X, const float* gamma, bf16_t* H, float* DT, const LAS float* wdt, int gw, int NGW, int lane) {
    lane = opq(lane);
    f32x4 g[4];
#pragma unroll
    for (int j = 0; j < 4; ++j) g[j] = *(const f32x4*)(gamma + 4 * lane + 256 * j);
    for (int m = gw; m < MTOK; m += 4 * NGW) {
        f32x4 v[4][4]; float s[4];
#pragma unroll
        for (int r = 0; r < 4; ++r) { const size_t xo = (size_t)(m + r * NGW) * DM + 4 * lane; s[r] = 0.f;
#pragma unroll
            for (int j = 0; j < 4; ++j) {
                if (IN_BF) { const u32x2 w = *(const u32x2*)((const bf16_t*)X + xo + 256 * j); v[r][j] = (f32x4){bf_lo(w.x), bf_hi(w.x), bf_lo(w.y), bf_hi(w.y)}; }
                else v[r][j] = *(const f32x4*)((const float*)X + xo + 256 * j);
                s[r] += (v[r][j].x * v[r][j].x + v[r][j].y * v[r][j].y) + (v[r][j].z * v[r][j].z + v[r][j].w * v[r][j].w); } }
#pragma unroll
        for (int r = 0; r < 4; ++r) {
            const float rinv = 1.f / sqrtf(wave_sum(s[r]) * (1.f / DM) + 1e-6f);
            bf16_t* hr = H + (size_t)(m + r * NGW) * DM + 4 * lane;
#pragma unroll
            for (int j = 0; j < 4; ++j) { v[r][j] = v[r][j] * rinv * g[j]; u32x2 o; o.x = pk2(v[r][j].x, v[r][j].y); o.y = pk2(v[r][j].z, v[r][j].w); *(u32x2*)(hr + 256 * j) = o; }
            if (WITH_DT) {
                float d[8];
#pragma unroll
                for (int q = 0; q < 8; ++q) { d[q] = 0.f;
#pragma unroll
                    for (int j = 0; j < 4; ++j) { const f32x4 w = *(const LAS f32x4*)(wdt + q * 1024 + 4 * lane + 256 * j); d[q] += (v[r][j].x * w.x + v[r][j].y * w.y) + (v[r][j].z * w.z + v[r][j].w * w.w); } }
#pragma unroll
                for (int q = 0; q < 8; ++q) d[q] = wave_sum(d[q]);
                if (lane == 0) { *(f32x4*)(DT + (size_t)(m + r * NGW) * 8) = (f32x4){d[0], d[1], d[2], d[3]}; *(f32x4*)(DT + (size_t)(m + r * NGW) * 8 + 4) = (f32x4){d[4], d[5], d[6], d[7]}; }
            }
        }
    }
}

__device__ __forceinline__ void phase_prep(KArgs ap_, int l, const void* X, LAS unsigned char* lds, int tid, int lane, int wave) {
    KArgs ap = ap_; asm volatile("" : "+s"(ap)); KArgsRef a = *ap; tid = opq(tid); lane = opq(lane);
    unsigned char* ws = a.ws;
    if ((int)blockIdx.x < 128) s5_prep(ap, l, blockIdx.x >> 2, blockIdx.x & 3, lds, tid);
    LAS float* scr = (LAS float*)(lds + wave * 8448);
    const int gw = blockIdx.x * NWAVES + wave, NGW = gridDim.x * NWAVES;
    const float* w_in = a.in[2] + (size_t)l * DM * IN_COLS;
    constexpr int I_WIN = 16 * 120, I_WG = 16 * 96, I_P = 8 * 32, I_GLU = 8 * 16, I_WOUT = 16 * 32, I_FIN = 16 * 176, I_FOUT = 44 * 32, I_UP = 16, I_GUP = 32;
    constexpr int NITEMS = I_WIN + I_WG + 3 * I_P + I_GLU + I_WOUT + I_FIN + I_FOUT + 2 * I_UP + I_GUP;
    const int NGWT = 3 * 128 * NWAVES;
    const int gwt = (int)blockIdx.x >= 128 ? ((int)blockIdx.x - 128) * NWAVES + wave : 2 * 128 * NWAVES + (int)blockIdx.x * NWAVES + wave;
    const int nslot = (int)blockIdx.x >= 128 ? 2 : 1;
    for (int sl = 0; sl < nslot; ++sl)
    for (int it = gwt + sl * 128 * NWAVES; it < NITEMS; it += NGWT) {
        int r = it;
        if (r < I_WIN) { const int kb = r / 120, nb = r % 120, n0 = 32 * nb, c0 = n0 < 3328 ? n0 : n0 + 8; tr_item(w_in, IN_COLS, 64 * kb, c0, (bf16_t*)(ws + WS_WIN), 1024, n0, scr, lane); continue; } r -= I_WIN;
        if (r < I_WG) { const int kb = r / 96, nb = r % 96, n0 = 32 * nb; tr_item(w_in, IN_COLS, 64 * kb, 3848 + n0, (bf16_t*)(ws + WS_WG), 1024, n0, scr, lane); continue; } r -= I_WG;
        if (r < I_P) { tr_item(a.in[14] + (size_t)l * 512 * 1024, 1024, 64 * (r / 32), 32 * (r % 32), (bf16_t*)(ws + WS_PA), 512, 32 * (r % 32), scr, lane); continue; } r -= I_P;
        if (r < I_P) { tr_item(a.in[21] + (size_t)l * 512 * 1024, 1024, 64 * (r / 32), 32 * (r % 32), (bf16_t*)(ws + WS_PB), 512, 32 * (r % 32), scr, lane); continue; } r -= I_P;
        if (r < I_P) { tr_item(a.in[32] + (size_t)l * 512 * 1024, 1024, 64 * (r / 32), 32 * (r % 32), (bf16_t*)(ws + WS_PC), 512, 32 * (r % 32), scr, lane); continue; } r -= I_P;
        if (r < I_GLU) { tr_item(a.in[30] + (size_t)l * 512 * 512, 512, 64 * (r / 16), 32 * (r % 16), (bf16_t*)(ws + WS_GLU), 512, 32 * (r % 16), scr, lane); continue; } r -= I_GLU;
        if (r < I_WOUT) { tr_item(a.in[33] + (size_t)l * 1024 * 1024, 1024, 64 * (r / 32), 32 * (r % 32), (bf16_t*)(ws + WS_WOUT), 1024, 32 * (r % 32), scr, lane); continue; } r -= I_WOUT;
        if (r < I_FIN) { const int kb = r / 176, nb = r % 176, c0 = ((nb >> 2) & 1) * FFH + 128 * (nb >> 3) + 32 * (nb & 3);
            tr_item(a.in[35] + (size_t)l * 1024 * 2 * FFH, 2 * FFH, 64 * kb, c0, (bf16_t*)(ws + WS_FIN), 1024, 32 * nb, scr, lane); continue; } r -= I_FIN;
        if (r < I_FOUT) { tr_item(a.in[36] + (size_t)l * FFH * 1024, 1024, 64 * (r / 32), 32 * (r % 32), (bf16_t*)(ws + WS_FOUT), FFH, 32 * (r % 32), scr, lane); continue; } r -= I_FOUT;
        if (r < I_UP) { tr_item(a.in[5] + (size_t)l * 64 * 512, 512, 0, 32 * r, (bf16_t*)(ws + WS_WUP), 64, 32 * r, scr, lane); continue; } r -= I_UP;
        if (r < I_UP) { tr_item(a.in[7] + (size_t)l * 64 * 512, 512, 0, 32 * r, (bf16_t*)(ws + WS_AUP), 64, 32 * r, scr, lane); continue; } r -= I_UP;
        tr_item(a.in[8] + (size_t)l * 128 * 512, 512, 64 * (r / 16), 32 * (r % 16), (bf16_t*)(ws + WS_GUP), 128, 32 * (r % 16), scr, lane);
    }
    __syncthreads();
    LAS float* wdt = (LAS float*)lds;
    for (int e = tid; e < 8192; e += NTHR) { const int k = e >> 3, q = e & 7; wdt[q * 1024 + k] = w_in[(size_t)k * IN_COLS + 3328 + q]; }
    __syncthreads();
    if (l == 0) rmsnorm_rows<true, false>(X, a.in[1] + l * DM, (bf16_t*)(ws + WS_H), (float*)(ws + WS_DT), wdt, gw, NGW, lane);
    else rmsnorm_rows<true, true>(X, a.in[1] + l * DM, (bf16_t*)(ws + WS_H), (float*)(ws + WS_DT), wdt, gw, NGW, lane);
    __syncthreads();
}

__device__ __forceinline__ void rwkv_act_pass(KArgs ap_, int l, int tid) {
    KArgs ap = ap_; asm volatile("" : "+s"(ap)); KArgsRef a = *ap; tid = opq(tid);
    const bf16_t* proj = (const bf16_t*)(a.ws + WS_PROJ);
    bf16_t* ACT = (bf16_t*)a.out + (size_t)MTOK * 1024;
    const int gt = blockIdx.x * NTHR + tid, GT = gridDim.x * NTHR;
    const int vec = gt & 31, col = P_WD + 8 * vec;
    const float* mu = a.in[3] + l * 1792 + col;
    const f32x4 m0 = *(const f32x4*)mu, m1 = *(const f32x4*)(mu + 4);
    for (int i = gt; i < MTOK * 32; i += 4 * GT) {
        u32x4 c[4], p[4];
#pragma unroll
        for (int r = 0; r < 4; ++r) { const int row = (i + r * GT) >> 5; const bf16_t* pr = proj + (size_t)row * NPROJ + col;
            c[r] = *(const u32x4*)pr; p[r] = (row & (SEQ - 1)) ? *(const u32x4*)(pr - NPROJ) : (u32x4){0u, 0u, 0u, 0u}; }
#pragma unroll
        for (int r = 0; r < 4; ++r) { const int row = (i + r * GT) >> 5;
            float cu[8], pv[8], v[8]; unpack8(c[r], cu); unpack8(p[r], pv);
#pragma unroll
            for (int e = 0; e < 4; ++e) { v[e] = cu[e] + (pv[e] - cu[e]) * m0[e]; v[4 + e] = cu[4 + e] + (pv[4 + e] - cu[4 + e]) * m1[e]; }
            if (vec < 8) {
#pragma unroll
                for (int e = 0; e < 8; ++e) v[e] = ftanh(v[e]); }
            else if (vec >= 16) {
#pragma unroll
                for (int e = 0; e < 8; ++e) v[e] = sigm(v[e]); }
            *(u32x4*)(ACT + (size_t)row * 256 + 8 * vec) = pack8(v); }
    }
}

constexpr int R_CT = 16, R_NCH = SEQ / R_CT;
constexpr int R_BW = 0, R_BA = 9216, R_BG = 18432, R_AW = 35840, R_AA = 38144, R_AG = 40448, R_VEC2 = 44800, R_VEC3 = 85760, R_BON = 110336, R_INV = 111104, R_OB = 111168;
struct StepV { f32x4 n0, n1, w0, w1, b0, b1, k0, k1, r0, r1; f32x2 vv; };
__device__ __forceinline__ StepV rw_load(const LAS float* v2, const LAS float* vvb, int t, int jj, int rp) {
    StepV s; const LAS float* p = v2 + t * 64 + 8 * jj;
    s.n0 = *(const LAS f32x4*)(p); s.n1 = *(const LAS f32x4*)(p + 4);
    s.w0 = *(const LAS f32x4*)(p + 1024); s.w1 = *(const LAS f32x4*)(p + 1028);
    s.b0 = *(const LAS f32x4*)(p + 2048); s.b1 = *(const LAS f32x4*)(p + 2052);
    s.k0 = *(const LAS f32x4*)(p + 3072); s.k1 = *(const LAS f32x4*)(p + 3076);
    s.r0 = *(const LAS f32x4*)(p + 4096); s.r1 = *(const LAS f32x4*)(p + 4100);
    s.vv = *(const LAS f32x2*)(vvb + t * 64 + 2 * rp);
    return s;
}
template <int CTRL> __device__ __forceinline__ float dppb(float x) { return __builtin_bit_cast(float, __builtin_amdgcn_update_dpp(0, __builtin_bit_cast(int, x), CTRL, 0xf, 0xf, true)); }
__device__ __forceinline__ float red8b(float x) { x += dppb<0xB1>(x); x += dppb<0x4E>(x); x += dppb<0x141>(x); return x; }
__device__ __forceinline__ void rw_step(f32x2 (&S)[8], const StepV& s, LAS float* ob, int t, int jj, int rp) {
    const f32x2 nA[4] = {{s.n0.x, s.n0.y}, {s.n0.z, s.n0.w}, {s.n1.x, s.n1.y}, {s.n1.z, s.n1.w}};
    const f32x2 wA[4] = {{s.w0.x, s.w0.y}, {s.w0.z, s.w0.w}, {s.w1.x, s.w1.y}, {s.w1.z, s.w1.w}};
    const f32x2 bA[4] = {{s.b0.x, s.b0.y}, {s.b0.z, s.b0.w}, {s.b1.x, s.b1.y}, {s.b1.z, s.b1.w}};
    const f32x2 kA[4] = {{s.k0.x, s.k0.y}, {s.k0.z, s.k0.w}, {s.k1.x, s.k1.y}, {s.k1.z, s.k1.w}};
    const f32x2 rA[4] = {{s.r0.x, s.r0.y}, {s.r0.z, s.r0.w}, {s.r1.x, s.r1.y}, {s.r1.z, s.r1.w}};
    f32x2 a0 = S[0] * nA[0], a1 = S[4] * nA[0];
#pragma unroll
    for (int i = 1; i < 4; ++i) { a0 += S[i] * nA[i]; a1 += S[4 + i] * nA[i]; }
    float sa0 = red8b(a0.x + a0.y), sa1 = red8b(a1.x + a1.y);
    const float v0 = s.vv.x, v1 = s.vv.y;
#pragma unroll
    for (int i = 0; i < 4; ++i) { S[i] = S[i] * wA[i] + (bA[i] * sa0 + kA[i] * v0); S[4 + i] = S[4 + i] * wA[i] + (bA[i] * sa1 + kA[i] * v1); }
    f32x2 o0 = S[0] * rA[0], o1 = S[4] * rA[0];
#pragma unroll
    for (int i = 1; i < 4; ++i) { o0 += S[i] * rA[i]; o1 += S[4 + i] * rA[i]; }
    f32x2 o; o.x = red8b(o0.x + o0.y); o.y = red8b(o1.x + o1.y);
    if (jj == 0) *(LAS f32x2*)(ob + t * 64 + 2 * rp) = o;
}
__device__ __forceinline__ void rwkv_unit(KArgs ap_, int l, int b, int h, LAS unsigned char* lds, int tid, int lane, int wave) {
    KArgs ap = ap_; asm volatile("" : "+s"(ap)); KArgsRef a = *ap; tid = opq(tid); lane = opq(lane);
    unsigned char* ws = a.ws;
    const bf16_t* proj = (const bf16_t*)(ws + WS_PROJ);
    bf16_t* Ya = (bf16_t*)(ws + WS_YA);
    LAS bf16_t* BW = (LAS bf16_t*)(lds + R_BW); LAS bf16_t* BA = (LAS bf16_t*)(lds + R_BA); LAS bf16_t* BG = (LAS bf16_t*)(lds + R_BG);
    LAS bf16_t* AW = (LAS bf16_t*)(lds + R_AW); LAS bf16_t* AA = (LAS bf16_t*)(lds + R_AA); LAS bf16_t* AG = (LAS bf16_t*)(lds + R_AG);
    LAS float* VEC2 = (LAS float*)(lds + R_VEC2);
    LAS float* VEC3 = (LAS float*)(lds + R_VEC3);
    LAS float* BONP = (LAS float*)(lds + R_BON);
    LAS float* INV = (LAS float*)(lds + R_INV);
    LAS float* OBB = (LAS float*)(lds + R_OB);
    const float* mu = a.in[3] + l * 1792;
    const float* w0 = a.in[4] + l * 512 + 64 * h; const float* a0 = a.in[6] + l * 512 + 64 * h;
    const float* k_k = a.in[9] + l * 512 + 64 * h; const float* k_a = a.in[10] + l * 512 + 64 * h; const float* r_k = a.in[11] + l * 512 + 64 * h;
    const float* ln_g = a.in[12] + l * 512 + 64 * h; const float* ln_b = a.in[13] + l * 512 + 64 * h;
    { const bf16_t* wup = (const bf16_t*)(ws + WS_WUP) + (size_t)64 * h * 64; const bf16_t* aup = (const bf16_t*)(ws + WS_AUP) + (size_t)64 * h * 64; const bf16_t* gup = (const bf16_t*)(ws + WS_GUP) + (size_t)64 * h * 128;
      { const int n = tid >> 3, c = tid & 7; *(LAS u32x4*)(BW + n * 72 + 8 * c) = *(const u32x4*)(wup + n * 64 + 8 * c); *(LAS u32x4*)(BA + n * 72 + 8 * c) = *(const u32x4*)(aup + n * 64 + 8 * c); }
      for (int e = tid; e < 1024; e += NTHR) { const int n = e >> 4, c = e & 15; *(LAS u32x4*)(BG + n * 136 + 8 * c) = *(const u32x4*)(gup + n * 128 + 8 * c); } }
    const bool is_scan = wave < 4;
    const size_t rowbase = (size_t)b * SEQ;
    f32x2 S[8];
#pragma unroll
    for (int i = 0; i < 8; ++i) S[i] = (f32x2){0.f, 0.f};
    const int rp = (tid >> 3) & 31, jj = tid & 7;
    const int pt = tid & 255, pw = wave & 3;
    const bf16_t* ACT = (const bf16_t*)a.out + (size_t)MTOK * 1024;
    u32x4 RC[2], RP[2], CC[2];
#pragma unroll
    for (int i = 0; i < 2; ++i) { RC[i] = (u32x4){0u, 0u, 0u, 0u}; RP[i] = (u32x4){0u, 0u, 0u, 0u}; CC[i] = (u32x4){0u, 0u, 0u, 0u}; }
    __syncthreads();

#define RW_LD(IDX, KIND, tok, colv, lcv, MU, DSTF, DSTB, LDB) do { \
    const int t_ = (cn_) * R_CT + (tok); const bf16_t* pr_ = proj + (rowbase + t_) * NPROJ + (colv); \
    RC[IDX] = *(const u32x4*)pr_; RP[IDX] = t_ > 0 ? *(const u32x4*)(pr_ - NPROJ) : (u32x4){0u, 0u, 0u, 0u}; } while (0)
#define RW_PAIR(IDX, KIND, tok, colv, lcv, MU, DSTF, DSTB, LDB) do { \
    float cur_[8], prv_[8], v_[8]; unpack8(RC[IDX], cur_); unpack8(RP[IDX], prv_); \
    { const f32x4 m0_ = *(const f32x4*)(mu + (colv)), m1_ = *(const f32x4*)(mu + (colv) + 4); \
      _Pragma("unroll") for (int e = 0; e < 4; ++e) { v_[e] = cur_[e] + (prv_[e] - cur_[e]) * m0_[e]; v_[4 + e] = cur_[4 + e] + (prv_[4 + e] - cur_[4 + e]) * m1_[e]; } } \
    if (KIND <= 2) { LAS float* d_ = (DSTF) + (tok) * 64 + (lcv); *(LAS f32x4*)d_ = (f32x4){v_[0], v_[1], v_[2], v_[3]}; *(LAS f32x4*)(d_ + 4) = (f32x4){v_[4], v_[5], v_[6], v_[7]}; \
        if (KIND == 1) { const f32x4 k0_ = *(const f32x4*)(k_k + (lcv)), k1_ = *(const f32x4*)(k_k + (lcv) + 4); float q_ = 0.f; _Pragma("unroll") for (int e = 0; e < 4; ++e) { const float x_ = v_[e] * k0_[e], y_ = v_[4 + e] * k1_[e]; q_ += x_ * x_ + y_ * y_; } q_ = red8b(q_); if (((lcv) >> 3) == 0) INV[tok] = __builtin_amdgcn_rsqf(fmaxf(q_, 1e-24f)); } } \
    else { if (KIND == 3) { _Pragma("unroll") for (int e = 0; e < 8; ++e) v_[e] = ftanh(v_[e]); } \
        if (KIND == 5) { _Pragma("unroll") for (int e = 0; e < 8; ++e) v_[e] = sigm(v_[e]); } \
        *(LAS u32x4*)((DSTB) + (tok) * (LDB) + (lcv)) = pack8(v_); } } while (0)
#define RW_FORPAIRS(OP) do { const int ln = opq(lane); \
    if (pw == 0) { _Pragma("unroll") for (int i = 0; i < 2; ++i) { const int tok = (ln >> 3) + 8 * i, lc = 8 * (ln & 7); OP(i, 0, tok, P_R + 64 * h + lc, lc, muA, v2 + 4096, AW, 72); } } \
    else if (pw == 1) { _Pragma("unroll") for (int i = 0; i < 2; ++i) { const int tok = (ln >> 3) + 8 * i, lc = 8 * (ln & 7); OP(i, 2, tok, P_V + 64 * h + lc, lc, muA, v3, AW, 72); } } \
    else { const int tok = (ln >> 3) + 8 * (pw - 2), lc = 8 * (ln & 7); OP(0, 1, tok, P_K + 64 * h + lc, lc, muA, v2 + 3072, AW, 72); } \
    } while (0)
#define RW_CPLD(cn) do { const int pt_ = opq(pt); _Pragma("unroll") for (int i = 0; i < 2; ++i) { const int ix_ = pt_ + 256 * i; \
        CC[i] = *(const u32x4*)(ACT + (rowbase + (cn) * R_CT + (ix_ >> 5)) * 256 + 8 * (ix_ & 31)); } } while (0)
#define RW_CPST() do { const int pt_ = opq(pt); _Pragma("unroll") for (int i = 0; i < 2; ++i) { const int ix_ = pt_ + 256 * i, tk_ = ix_ >> 5, vc_ = ix_ & 31; \
        const int ad_ = vc_ < 8 ? R_AW + tk_ * 144 + 16 * vc_ : (vc_ < 16 ? R_AA + tk_ * 144 + 16 * (vc_ - 8) : R_AG + tk_ * 272 + 16 * (vc_ - 16)); \
        *(LAS u32x4*)(lds + ad_) = CC[i]; } } while (0)
#define RW_LOAD(cn) do { const int cn_ = (cn); LAS float* v2 = nullptr; LAS float* v3 = nullptr; (void)v2; (void)v3; RW_FORPAIRS(RW_LD); RW_CPLD(cn_); } while (0)
#define RW_PREP1(cn) do { const int cn_ = (cn); (void)cn_; \
    LAS float* v2 = VEC2 + (cn_ & 1) * 5120; LAS float* v3 = VEC3 + (cn_ % 3) * 2048; RW_FORPAIRS(RW_PAIR); RW_CPST(); } while (0)

#define RW_PREP2(cn) do { const int ln2 = opq(lane); const int r16 = ln2 & 15, q4 = ln2 >> 4, kq = 8 * q4, nn = 16 * pw + r16; \
    const float w0n = w0[nn], a0n = a0[nn], kkn = k_k[nn], kan = k_a[nn], rkn = r_k[nn]; \
    LAS float* v2 = VEC2 + ((cn) & 1) * 5120; LAS float* v3 = VEC3 + ((cn) % 3) * 2048; LAS float* bp = BONP + ((cn) % 3) * 64; \
    const f32x4 z4_ = {0.f, 0.f, 0.f, 0.f}; \
    f32x4 cw = MFMA16(ldsfrag(AW, r16, 72, kq), ldsfrag(BW, 16 * pw + r16, 72, kq), z4_); cw = MFMA16(ldsfrag(AW, r16, 72, 32 + kq), ldsfrag(BW, 16 * pw + r16, 72, 32 + kq), cw); \
    f32x4 ca = MFMA16(ldsfrag(AA, r16, 72, kq), ldsfrag(BA, 16 * pw + r16, 72, kq), z4_); ca = MFMA16(ldsfrag(AA, r16, 72, 32 + kq), ldsfrag(BA, 16 * pw + r16, 72, 32 + kq), ca); \
    f32x4 cgt = MFMA16(ldsfrag(AG, r16, 136, kq), ldsfrag(BG, 16 * pw + r16, 136, kq), z4_); \
    _Pragma("unroll") for (int ks = 1; ks < 4; ++ks) cgt = MFMA16(ldsfrag(AG, r16, 136, 32 * ks + kq), ldsfrag(BG, 16 * pw + r16, 136, 32 * ks + kq), cgt); \
    _Pragma("unroll") for (int j = 0; j < 4; ++j) { const int tok = 4 * q4 + j; \
        const float wv = __expf(-0.6065306597f * sigm(w0n + cw[j])); const float av = sigm(a0n + ca[j]); \
        const float kr = v2[3072 + tok * 64 + nn], rr = v2[4096 + tok * 64 + nn], inv = INV[tok]; \
        const float kk = kr * kkn * inv, kp = kr * (1.f + (av - 1.f) * kan); \
        v2[tok * 64 + nn] = -kk; v2[1024 + tok * 64 + nn] = wv; v2[2048 + tok * 64 + nn] = kk * av; v2[3072 + tok * 64 + nn] = kp; \
        v3[1024 + tok * 64 + nn] = cgt[j]; \
        float bs = rr * kp * rkn; bs = red16(bs); if (r16 == 0) bp[tok * 4 + pw] = bs; } \
    } while (0)

#define RW_FIN(cf) do { \
    const LAS float* ob = OBB + ((cf) & 1) * 1024; const LAS float* v3 = VEC3 + ((cf) % 3) * 2048; const LAS float* bp = BONP + ((cf) % 3) * 64; \
    const int pt_ = opq(pt); const int tok = pt_ >> 4, sub = pt_ & 15, n0 = 4 * sub; \
    const f32x4 o = *(const LAS f32x4*)(ob + tok * 64 + n0); \
    float s = (o.x + o.y) + (o.z + o.w); s = red16(s); \
    const float mean = s * (1.f / 64.f); const f32x4 d = o - mean; \
    float q = (d.x * d.x + d.y * d.y) + (d.z * d.z + d.w * d.w); q = red16(q); \
    const float rstd = __builtin_amdgcn_rsqf(q * (1.f / 64.f) + 64e-5f); \
    const f32x4 lg = *(const f32x4*)(ln_g + n0), lb = *(const f32x4*)(ln_b + n0); \
    const f32x4 vv = *(const LAS f32x4*)(v3 + tok * 64 + n0), gg = *(const LAS f32x4*)(v3 + 1024 + tok * 64 + n0); \
    const f32x4 bq = *(const LAS f32x4*)(bp + tok * 4); const float bon = (bq.x + bq.y) + (bq.z + bq.w); \
    const f32x4 y = (d * rstd * lg + lb + vv * bon) * gg; \
    u32x2 w; w.x = pk2(y.x, y.y); w.y = pk2(y.z, y.w); \
    *(u32x2*)(Ya + (rowbase + (cf) * R_CT + tok) * 512 + 64 * h + n0) = w; } while (0)

#define RW_SCAN8(c, t0) do { \
    const int a2_ = opq(R_VEC2 + ((c) & 1) * 20480 + 32 * jj), a3_ = opq(R_VEC3 + ((c) % 3) * 8192 + 8 * rp), ao_ = opq(R_OB + ((c) & 1) * 4096 + 8 * rp); \
    const LAS float* v2 = (const LAS float*)(lds + a2_); const LAS float* vvb = (const LAS float*)(lds + a3_); LAS float* ob = (LAS float*)(lds + ao_); \
    StepV cur = rw_load(v2, vvb, (t0), 0, 0); \
    _Pragma("unroll") for (int i = 0; i < 8; ++i) { StepV nxt; if (i < 7) nxt = rw_load(v2, vvb, (t0) + i + 1, 0, 0); \
        rw_step(S, cur, ob, (t0) + i, jj, 0); if (i < 7) cur = nxt; } } while (0)

    if (!is_scan) { RW_LOAD(0); RW_PREP1(0); RW_LOAD(1); }
    __syncthreads();
    if (!is_scan) RW_PREP2(0);
    __syncthreads();
#pragma unroll 1
    for (int c = 0; c < R_NCH; ++c) {
        if (is_scan) { RW_SCAN8(c, 0); } else { if (c + 1 < R_NCH) RW_PREP1(c + 1); if (c + 2 < R_NCH) RW_LOAD(c + 2); }
        __syncthreads();
        if (is_scan) { RW_SCAN8(c, 8); } else { if (c + 1 < R_NCH) RW_PREP2(c + 1); if (c >= 1) RW_FIN(c - 1); }
        __syncthreads();
    }
    if (!is_scan) RW_FIN(R_NCH - 1);
    __syncthreads();
#undef RW_PREP1
#undef RW_LOAD
#undef RW_CPLD
#undef RW_CPST
#undef RW_LD
#undef RW_PAIR
#undef RW_FORPAIRS
#undef RW_PREP2
#undef RW_FIN
#undef RW_SCAN8
}

constexpr int S_LD = 136;
constexpr int S_CS = 0, S_BS = 34816, S_BT = 69632, S_XT = 104448, S_SB = 121856, S_ACS = 139264, S_DTV = 139776;
__device__ __forceinline__ void ssd_unit(KArgs ap_, int l, int b, int h, LAS unsigned char* lds, int tid, int lane, int wave) {
    KArgs ap = ap_; asm volatile("" : "+s"(ap)); KArgsRef a = *ap; tid = opq(tid); lane = opq(lane);
    unsigned char* ws = a.ws;
    const bf16_t* proj = (const bf16_t*)(ws + WS_PROJ);
    const float* dtraw = (const float*)(ws + WS_DT);
    bf16_t* Yb = (bf16_t*)(ws + WS_YB);
    LAS bf16_t* Cs = (LAS bf16_t*)(lds + S_CS); LAS bf16_t* Bs = (LAS bf16_t*)(lds + S_BS); LAS bf16_t* BT = (LAS bf16_t*)(lds + S_BT);
    LAS bf16_t* XT = (LAS bf16_t*)(lds + S_XT); LAS bf16_t* SB = (LAS bf16_t*)(lds + S_SB);
    LAS float* ACS = (LAS float*)(lds + S_ACS); LAS float* DTV = (LAS float*)(lds + S_DTV);
    const int g = h >> 2;
    const float* cw = a.in[15] + (size_t)l * 4 * 1024; const float* cb = a.in[16] + l * 1024;
    const float dtb = a.in[17][l * 8 + h], Ah = -expf(a.in[18][l * 8 + h]), Dh = a.in[19][l * 8 + h];
    const size_t rowbase = (size_t)b * SEQ;
    const int r16 = lane & 15, q4 = lane >> 4, kq = 8 * q4;
    f32x4 st[4];
#pragma unroll
    for (int i = 0; i < 4; ++i) st[i] = (f32x4){0.f, 0.f, 0.f, 0.f};
    for (int e = tid; e < 64 * S_LD / 2; e += NTHR) ((LAS unsigned*)SB)[e] = 0u;
    __syncthreads();
    for (int t0 = 0; t0 < SEQ; t0 += 128) {
        if (tid < 128) { const float z_ = dtraw[(rowbase + t0 + tid) * 8 + h] + dtb; DTV[tid] = z_ > 20.f ? z_ : __logf(1.f + __expf(z_)); }
        __syncthreads();
        if (wave == 0) { const float a0 = DTV[2 * lane] * Ah, a1 = DTV[2 * lane + 1] * Ah; float s = a0 + a1;
#pragma unroll
            for (int o = 1; o < 64; o <<= 1) { const float t = __shfl_up(s, o); if (lane >= o) s += t; }
            ACS[2 * lane + 1] = s; ACS[2 * lane] = s - a1; }
        __syncthreads();
        const float acsL = ACS[127];
        for (int item = tid; item < 640; item += NTHR) {
            int tg, col, kind, lc;
            if (item < 512) { const int sub = item & 31; tg = item >> 5;
                if (sub < 8) { kind = 0; lc = 8 * sub; col = P_XS + 64 * h + lc; }
                else if (sub < 24) { kind = 1; lc = 8 * (sub - 8); col = P_B + 128 * g + lc; }
                else { kind = 2; lc = 8 * (sub - 24); col = P_C + 128 * g + lc; } }
            else { const int r_ = item - 512; kind = 2; tg = r_ >> 3; lc = 64 + 8 * (r_ & 7); col = P_C + 128 * g + lc; }
            const int l0 = 8 * tg;
            const int cc = col - P_XS;
            u32x4 in[11];
#pragma unroll
            for (int i = 0; i < 11; ++i) { const int t = t0 + l0 - 3 + i; in[i] = t >= 0 ? *(const u32x4*)(proj + (rowbase + t) * NPROJ + col) : (u32x4){0u, 0u, 0u, 0u}; }
            float wj[4][8], bias[8];
#pragma unroll
            for (int j = 0; j < 4; ++j) { const f32x4 x0 = *(const f32x4*)(cw + j * 1024 + cc), x1 = *(const f32x4*)(cw + j * 1024 + cc + 4);
                wj[j][0] = x0.x; wj[j][1] = x0.y; wj[j][2] = x0.z; wj[j][3] = x0.w; wj[j][4] = x1.x; wj[j][5] = x1.y; wj[j][6] = x1.z; wj[j][7] = x1.w; }
            { const f32x4 x0 = *(const f32x4*)(cb + cc), x1 = *(const f32x4*)(cb + cc + 4); bias[0] = x0.x; bias[1] = x0.y; bias[2] = x0.z; bias[3] = x0.w; bias[4] = x1.x; bias[5] = x1.y; bias[6] = x1.z; bias[7] = x1.w; }
            float out[8][8];
#pragma unroll
            for (int tt = 0; tt < 8; ++tt)
#pragma unroll
                for (int e = 0; e < 8; ++e) out[tt][e] = bias[e];
#pragma unroll
            for (int i = 0; i < 11; ++i) { float x[8]; unpack8(in[i], x);
#pragma unroll
                for (int j = 0; j < 4; ++j) { const int tt = i - j;
                    if (tt >= 0 && tt < 8) {
#pragma unroll
                        for (int e = 0; e < 8; ++e) out[tt][e] += wj[j][e] * x[e]; } } }
#pragma unroll
            for (int tt = 0; tt < 8; ++tt)
#pragma unroll
                for (int e = 0; e < 8; ++e) out[tt][e] = out[tt][e] * sigm(out[tt][e]);
            if (kind == 0) {
                float dtl[8];
#pragma unroll
                for (int tt = 0; tt < 8; ++tt) dtl[tt] = DTV[l0 + tt];
#pragma unroll
                for (int e = 0; e < 8; ++e) { float c[8];
#pragma unroll
                    for (int tt = 0; tt < 8; ++tt) c[tt] = out[tt][e] * dtl[tt];
                    *(LAS u32x4*)(XT + (lc + e) * S_LD + l0) = pack8(c); }
            } else if (kind == 1) {
                float dec[8];
#pragma unroll
                for (int tt = 0; tt < 8; ++tt) dec[tt] = __expf(acsL - ACS[l0 + tt]);
#pragma unroll
                for (int tt = 0; tt < 8; ++tt) *(LAS u32x4*)(Bs + (l0 + tt) * S_LD + lc) = pack8(out[tt]);
#pragma unroll
                for (int e = 0; e < 8; ++e) { float c[8];
#pragma unroll
                    for (int tt = 0; tt < 8; ++tt) c[tt] = out[tt][e] * dec[tt];
                    *(LAS u32x4*)(BT + (lc + e) * S_LD + l0) = pack8(c); }
            } else {
#pragma unroll
                for (int tt = 0; tt < 8; ++tt) *(LAS u32x4*)(Cs + (l0 + tt) * S_LD + lc) = pack8(out[tt]);
            }
        }
        __syncthreads();
        f32x4 sc[8];
#pragma unroll
        for (int i = 0; i < 8; ++i) sc[i] = (f32x4){0.f, 0.f, 0.f, 0.f};
#pragma unroll
        for (int ks = 0; ks < 4; ++ks) { const bf16x8 af = ldsfrag(Cs, 16 * wave + r16, S_LD, 32 * ks + kq);
#pragma unroll
            for (int s = 0; s < 8; ++s) sc[s] = MFMA16(af, ldsfrag(Bs, 16 * s + r16, S_LD, 32 * ks + kq), sc[s]); }
        __syncthreads();
        {
            float al[4], dl[4];
#pragma unroll
            for (int j = 0; j < 4; ++j) { al[j] = ACS[16 * wave + 4 * q4 + j]; dl[j] = Dh / DTV[16 * wave + 4 * q4 + j]; }
#pragma unroll
            for (int s = 0; s < 8; ++s) { const int sidx = 16 * s + r16; const float as = ACS[sidx];
#pragma unroll
                for (int j = 0; j < 4; ++j) { const int lidx = 16 * wave + 4 * q4 + j;
                    float v = sidx <= lidx ? sc[s][j] * __expf(al[j] - as) : 0.f; if (sidx == lidx) v += dl[j];
                    Bs[lidx * S_LD + sidx] = (bf16_t)f2bf(v); } }
        }
        __syncthreads();
        {
            f32x4 yd[4], yo[4];
#pragma unroll
            for (int i = 0; i < 4; ++i) { yd[i] = (f32x4){0.f, 0.f, 0.f, 0.f}; yo[i] = (f32x4){0.f, 0.f, 0.f, 0.f}; }
#pragma unroll
            for (int ks = 0; ks < 4; ++ks) { const bf16x8 am = ldsfrag(Bs, 16 * wave + r16, S_LD, 32 * ks + kq), ac = ldsfrag(Cs, 16 * wave + r16, S_LD, 32 * ks + kq);
#pragma unroll
                for (int pt = 0; pt < 4; ++pt) { yd[pt] = MFMA16(am, ldsfrag(XT, 16 * pt + r16, S_LD, 32 * ks + kq), yd[pt]);
                    yo[pt] = MFMA16(ac, ldsfrag(SB, 16 * pt + r16, S_LD, 32 * ks + kq), yo[pt]); } }
#pragma unroll
            for (int j = 0; j < 4; ++j) { const int lidx = 16 * wave + 4 * q4 + j; const float ea = __expf(ACS[lidx]);
                const size_t row = rowbase + t0 + lidx;
#pragma unroll
                for (int pt = 0; pt < 4; ++pt) { const int p = 16 * pt + r16;
                    const float z = bf2f(proj[row * NPROJ + P_Z + 64 * h + p]);
                    const float y = (yd[pt][j] + ea * yo[pt][j]) * (z * sigm(z));
                    Yb[row * 512 + 64 * h + p] = (bf16_t)f2bf(y); } }
        }
        {
            const float dec = __expf(acsL);
#pragma unroll
            for (int pt = 0; pt < 4; ++pt) st[pt] = st[pt] * dec;
#pragma unroll
            for (int ks = 0; ks < 4; ++ks) { const bf16x8 bf = ldsfrag(BT, 16 * wave + r16, S_LD, 32 * ks + kq);
#pragma unroll
                for (int pt = 0; pt < 4; ++pt) st[pt] = MFMA16(ldsfrag(XT, 16 * pt + r16, S_LD, 32 * ks + kq), bf, st[pt]); }
        }
        __syncthreads();
#pragma unroll
        for (int pt = 0; pt < 4; ++pt)
#pragma unroll
            for (int j = 0; j < 4; ++j) SB[(16 * pt + 4 * q4 + j) * S_LD + 16 * wave + r16] = (bf16_t)f2bf(st[pt][j]);
    }
    __syncthreads();
}

constexpr int F_U = 0, F_SP = 67584;
__device__ __forceinline__ float gelu_tanh(float x) { const float u = 0.7978845608028654f * (x + 0.044715f * x * x * x); return 0.5f * x * (1.f + ftanh(u)); }
__device__ __forceinline__ void s5_unit(KArgs ap_, int l, int b, int g, LAS unsigned char* lds, int tid, int lane, int wave) {
    KArgs ap = ap_; asm volatile("" : "+s"(ap)); KArgsRef a = *ap; tid = opq(tid); lane = opq(lane);
    unsigned char* ws = a.ws;
    const bf16_t* proj = (const bf16_t*)(ws + WS_PROJ);
    bf16_t* ZG = (bf16_t*)(ws + WS_ZG);
    const bf16_t* tm = (const bf16_t*)(ws + WS_TM) + (size_t)g * 384 * 256;
    const bf16_t* m3 = (const bf16_t*)(ws + WS_M3) + (size_t)g * 256 * 128;
    const float* A16 = (const float*)(ws + WS_A16) + g * 128;
    LAS bf16_t* U = (LAS bf16_t*)(lds + F_U); LAS float* ST = (LAS float*)(lds + F_U); LAS bf16_t* SP = (LAS bf16_t*)(lds + F_SP);
    LAS unsigned char* ZL = lds + F_U;
    const size_t rowbase = (size_t)b * SEQ;
    const int r16 = lane & 15, q4 = lane >> 4, kq = 8 * q4;
    u32x4 ur[8];
#pragma unroll
    for (int j = 0; j < 8; ++j) { const int i = tid + NTHR * j, t = i >> 1, hf = i & 1; ur[j] = *(const u32x4*)(proj + (rowbase + t) * NPROJ + P_U + 16 * g + 8 * hf); }
    bf16x8 bf[8][3];
#pragma unroll
    for (int ks = 0; ks < 4; ++ks) { const int k = 32 * ks + kq;
        bf[ks][0] = *(const bf16x8*)(tm + (size_t)(32 * wave + r16) * 256 + k); bf[ks][1] = *(const bf16x8*)(tm + (size_t)(32 * wave + 16 + r16) * 256 + k); bf[ks][2] = *(const bf16x8*)(tm + (size_t)(256 + 16 * wave + r16) * 256 + k); }
#pragma unroll
    for (int j = 0; j < 8; ++j) { const int i = tid + NTHR * j, t = i >> 1, hf = i & 1; *(LAS u32x4*)(U + (t >> 4) * 264 + (t & 15) * 16 + 8 * hf) = ur[j]; }
    asm volatile("" ::: "memory");
#pragma unroll
    for (int ks = 4; ks < 8; ++ks) { const int k = 32 * ks + kq;
        bf[ks][0] = *(const bf16x8*)(tm + (size_t)(32 * wave + r16) * 256 + k); bf[ks][1] = *(const bf16x8*)(tm + (size_t)(32 * wave + 16 + r16) * 256 + k); bf[ks][2] = *(const bf16x8*)(tm + (size_t)(256 + 16 * wave + r16) * 256 + k); }
    __syncthreads();
    f32x4 ay[8][2], as_[8];
#pragma unroll
    for (int m = 0; m < 8; ++m) { ay[m][0] = (f32x4){0.f, 0.f, 0.f, 0.f}; ay[m][1] = (f32x4){0.f, 0.f, 0.f, 0.f}; as_[m] = (f32x4){0.f, 0.f, 0.f, 0.f}; }
#pragma unroll
    for (int ks = 0; ks < 8; ++ks) { const int k = 32 * ks + kq;
#pragma unroll
        for (int m = 0; m < 8; ++m) { const bf16x8 af = ldsfrag(U, 16 * m + r16, 264, k);
            ay[m][0] = MFMA16(af, bf[ks][0], ay[m][0]); ay[m][1] = MFMA16(af, bf[ks][1], ay[m][1]); as_[m] = MFMA16(af, bf[ks][2], as_[m]); } }
    bf16x8 mf[4][2];
#pragma unroll
    for (int ks = 0; ks < 4; ++ks) { const int k = 32 * ks + kq;
        mf[ks][0] = *(const bf16x8*)(m3 + (size_t)(32 * wave + r16) * 128 + k); mf[ks][1] = *(const bf16x8*)(m3 + (size_t)(32 * wave + 16 + r16) * 128 + k); }
    __syncthreads();
#pragma unroll
    for (int m = 0; m < 8; ++m)
#pragma unroll
        for (int j = 0; j < 4; ++j) ST[(16 * m + 4 * q4 + j) * 128 + 16 * wave + r16] = as_[m][j];
    __syncthreads();
    if (tid < 64) { const int n = tid; const float ar = A16[2 * n], ai = A16[2 * n + 1]; float sr = 0.f, si = 0.f;
#pragma unroll 8
        for (int c = 0; c < 128; ++c) { *(LAS unsigned*)(SP + c * 136 + 2 * n) = pk2(sr, si);
            const f32x2 t = *(LAS f32x2*)(ST + c * 128 + 2 * n);
            const float nr = ar * sr - ai * si + t.x, ni = ar * si + ai * sr + t.y; sr = nr; si = ni; } }
    __syncthreads();
#pragma unroll
    for (int ks = 0; ks < 4; ++ks) { const int k = 32 * ks + kq;
#pragma unroll
        for (int m = 0; m < 8; ++m) { const bf16x8 af = ldsfrag(SP, 16 * m + r16, 136, k);
            ay[m][0] = MFMA16(af, mf[ks][0], ay[m][0]); ay[m][1] = MFMA16(af, mf[ks][1], ay[m][1]); } }
    __syncthreads();
#pragma unroll
    for (int m = 0; m < 8; ++m)
#pragma unroll
        for (int e = 0; e < 2; ++e)
#pragma unroll
            for (int j = 0; j < 4; ++j) { const int c = 16 * m + 4 * q4 + j, tok = 16 * c + 2 * wave + e;
                *(LAS bf16_t*)(ZL + tok * 32 + c * 32 + 2 * r16) = (bf16_t)f2bf(gelu_tanh(ay[m][e][j])); }
    __syncthreads();
#pragma unroll
    for (int j = 0; j < 8; ++j) { const int i = tid + NTHR * j, t = i >> 1, hf = i & 1;
        *(u32x4*)(ZG + (rowbase + t) * 512 + 16 * g + 8 * hf) = *(const LAS u32x4*)(ZL + t * 32 + (t >> 4) * 32 + 16 * hf); }
    __syncthreads();
}

__device__ __forceinline__ void ssd_norm_rows(KArgs ap_, int l, int gw, int NGW, int lane) {
    KArgs ap = ap_; asm volatile("" : "+s"(ap)); KArgsRef a = *ap; lane = opq(lane);
    bf16_t* Yb = (bf16_t*)(a.ws + WS_YB);
    const float* ng = a.in[20] + l * 512 + 8 * lane;
    const f32x4 g0 = *(const f32x4*)ng, g1 = *(const f32x4*)(ng + 4);
    for (int m = gw; m < MTOK; m += 4 * NGW) {
        u32x4 raw[4];
#pragma unroll
        for (int r = 0; r < 4; ++r) raw[r] = *(const u32x4*)(Yb + (size_t)(m + r * NGW) * 512 + 8 * lane);
#pragma unroll
        for (int r = 0; r < 4; ++r) {
            float v[8]; unpack8(raw[r], v);
            float s = 0.f;
#pragma unroll
            for (int e = 0; e < 8; ++e) s += v[e] * v[e];
            s = red32(s);
            const float rinv = __builtin_amdgcn_rsqf(s * (1.f / 256.f) + 1e-5f);
            v[0] *= rinv * g0.x; v[1] *= rinv * g0.y; v[2] *= rinv * g0.z; v[3] *= rinv * g0.w; v[4] *= rinv * g1.x; v[5] *= rinv * g1.y; v[6] *= rinv * g1.z; v[7] *= rinv * g1.w;
            *(u32x4*)(Yb + (size_t)(m + r * NGW) * 512 + 8 * lane) = pack8(v);
        }
    }
}

__device__ __forceinline__ void final_norm_rows(const bf16_t* X, float* O, const float* gamma, int gw, int NGW, int lane) {
    lane = opq(lane);
    f32x4 g[4];
#pragma unroll
    for (int j = 0; j < 4; ++j) g[j] = *(const f32x4*)(gamma + 4 * lane + 256 * j);
    for (int m = gw; m < MTOK; m += 4 * NGW) {
        f32x4 v[4][4]; float s[4];
#pragma unroll
        for (int r = 0; r < 4; ++r) { const bf16_t* xr = X + (size_t)(m + r * NGW) * DM + 4 * lane; s[r] = 0.f;
#pragma unroll
            for (int j = 0; j < 4; ++j) { const u32x2 w = *(const u32x2*)(xr + 256 * j); v[r][j] = (f32x4){bf_lo(w.x), bf_hi(w.x), bf_lo(w.y), bf_hi(w.y)};
                s[r] += (v[r][j].x * v[r][j].x + v[r][j].y * v[r][j].y) + (v[r][j].z * v[r][j].z + v[r][j].w * v[r][j].w); } }
#pragma unroll
        for (int r = 0; r < 4; ++r) { float* xr = O + (size_t)(m + r * NGW) * DM + 4 * lane;
            const float rinv = 1.f / sqrtf(wave_sum(s[r]) * (1.f / DM) + 1e-6f);
#pragma unroll
            for (int j = 0; j < 4; ++j) *(f32x4*)(xr + 256 * j) = v[r][j] * rinv * g[j]; }
    }
}

#define XB_TMO      128
#define XB_XCNT(j)  (256  + 64 * (j))
#define XB_XSUB(j)  (1280 + 64 * (j))
#define XB_XGEN(j)  (2304 + 64 * (j))
#define XB_TOP      3328
#define XB_TOPGEN   3392
#define XCD_BAR_WORDS 3456
#define XB_SPIN_CAP (1u << 18)

__device__ __forceinline__ unsigned xb_ld(unsigned* p)              { return __hip_atomic_load(p, __ATOMIC_RELAXED, __HIP_MEMORY_SCOPE_AGENT); }
__device__ __forceinline__ unsigned xb_add(unsigned* p, unsigned v) { return __hip_atomic_fetch_add(p, v, __ATOMIC_RELAXED, __HIP_MEMORY_SCOPE_AGENT); }
__device__ __forceinline__ unsigned xb_xcc_id() { return (unsigned)__builtin_amdgcn_s_getreg((3 << 11) | 20) & 0xFu; }
#define XB_SPIN(cond, bar) do { unsigned _sp = 0; while (cond) { __builtin_amdgcn_s_sleep(1); \
    if ((++_sp & 255u) == 0u) { if (xb_ld(&(bar)[XB_TMO])) break; if (_sp > XB_SPIN_CAP) { atomicAdd(&(bar)[XB_TMO], 1u); break; } } } } while (0)

struct XcdBarrier {
    unsigned* bar; unsigned x; unsigned G;
    volatile LAS unsigned* st;
};

__device__ __forceinline__ XcdBarrier xcd_barrier_post(unsigned* bar, volatile LAS unsigned* st) {
    XcdBarrier b; b.bar = bar; b.x = xb_xcc_id(); b.st = st; b.G = gridDim.x;
    if (threadIdx.x == 0) (void)xb_add(&bar[XB_XCNT(b.x)], 1u);
    return b;
}
__device__ __forceinline__ void xcd_barrier_complete(unsigned* bar, unsigned x, unsigned G, unsigned& nloc, unsigned& nx) {
    unsigned sum, cnt, mine, sp = 0u;
    for (;;) {
        sum = 0u; cnt = 0u; mine = 0u;
#pragma unroll
        for (unsigned j = 0; j < 16; ++j) { const unsigned c = xb_ld(&bar[XB_XCNT(j)]); sum += c; cnt += (c > 0u) ? 1u : 0u; mine = (j == x) ? c : mine; }
        if (sum == G) break;
        __builtin_amdgcn_s_sleep(1);
        if ((++sp & 255u) == 0u) { if (xb_ld(&bar[XB_TMO])) break; if (sp > XB_SPIN_CAP) { atomicAdd(&bar[XB_TMO], 1u); break; } }
    }
    nloc = mine > 0u ? mine : 1u; nx = cnt > 0u ? cnt : 1u;
}

__device__ __forceinline__ void xcd_barrier(const XcdBarrier& b) {
    asm volatile("s_waitcnt vmcnt(0)" ::: "memory");
    __syncthreads();
    if (threadIdx.x == 0) {
        unsigned* bar = b.bar;
        __builtin_amdgcn_s_waitcnt(0);
        unsigned nloc = b.st[0], nx = b.st[1];
        if (nloc == 0u) { xcd_barrier_complete(bar, b.x, b.G, nloc, nx); b.st[0] = nloc; b.st[1] = nx; }
        const unsigned old = xb_add(&bar[XB_XSUB(b.x)], 1u);
        const unsigned gen = old / nloc;
        if (old + 1u == (gen + 1u) * nloc) {
            __builtin_amdgcn_fence(__ATOMIC_RELEASE, "agent");
            asm volatile("s_waitcnt vmcnt(0)" ::: "memory");
            const unsigned og = xb_add(&bar[XB_TOP], 1u);
            const unsigned tg = og / nx;
            if (og + 1u == (tg + 1u) * nx) xb_add(&bar[XB_TOPGEN], 1u);
            else XB_SPIN(xb_ld(&bar[XB_TOPGEN]) == tg, bar);
            __builtin_amdgcn_fence(__ATOMIC_ACQUIRE, "agent");
            xb_add(&bar[XB_XGEN(b.x)], 1u);
            asm volatile("s_waitcnt vmcnt(0)" ::: "memory");
        } else {
            XB_SPIN(xb_ld(&bar[XB_XGEN(b.x)]) == gen, bar);
            __builtin_amdgcn_fence(__ATOMIC_ACQUIRE, "agent");
            asm volatile("s_waitcnt vmcnt(0)" ::: "memory");
        }
    }
    __syncthreads();
}


#ifndef PHM
#define PHM 63
#endif
#define GEMM_PHASE(EPI, AOFF, BOFF, N_, K_, E_) do { pg8::Gemm g_{(const pg8::bf16_t*)(ws + (AOFF)), (const pg8::bf16_t*)(ws + (BOFF)), MTOK, (N_), (K_)}; pg8::StaticOrder S_; S_.init(MTOK, (N_), (int)gridDim.x, (int)blockIdx.x); \
    pg8::gemm_phase<EPI, pg8::StaticOrder, true, true>(lds, g_, S_, (E_)); } while (0)
#define FRESH() KArgs ap = kargs(); unsigned char* ws = ap->ws; (void)ws

__global__ void __launch_bounds__(NTHR, 2) hybrid_fwd(Args a_unused) {
    extern __shared__ __attribute__((aligned(16))) unsigned char lds_raw[];
    LAS unsigned char* lds = (LAS unsigned char*)lds_raw;
    cg::grid_group grid = cg::this_grid();
    volatile LAS unsigned* bst = (volatile LAS unsigned*)(lds + LDS_BYTES - 64);
    if (threadIdx.x < 4) bst[threadIdx.x] = 0u;
    __syncthreads();
    XcdBarrier xbar = xcd_barrier_post((unsigned*)kargs()->ws, bst);
    XcdBarrier xsub = xbar;
    if ((int)blockIdx.x >= 128) { xsub = xcd_barrier_post((unsigned*)kargs()->ws + 4096, bst + 2); xsub.G = gridDim.x - 128; }
    grid.sync();
    const int tid = threadIdx.x, lane = tid & 63, wave = __builtin_amdgcn_readfirstlane(tid >> 6);
    const int gw = blockIdx.x * NWAVES + wave, NGW = gridDim.x * NWAVES;
#pragma unroll 1
    for (int l = 0; l < DEPTH; ++l) {
        { FRESH();
#ifndef NO_PREP
          phase_prep(ap, l, l == 0 ? (const void*)ap->in[0] : (const void*)ap->out, lds, tid, lane, wave);
#endif
        }
        xcd_barrier(xbar);
        if (PHM & 1) { FRESH(); pg8::EpiStore E{(bf16_t*)(ws + WS_PROJ), NPROJ}; GEMM_PHASE(pg8::EpiStore, WS_H, WS_WIN, NPROJ, 1024, E); }
        xcd_barrier(xbar);
#ifndef REPC
#define REPC 1
#endif
#pragma unroll 1
        for (int rep = 0; rep < REPC; ++rep) { FRESH();
          rwkv_act_pass(ap, l, tid); xcd_barrier(xbar);
          if ((int)blockIdx.x < 128) {
#ifndef NO_RWKV
            rwkv_unit(ap, l, blockIdx.x >> 3, blockIdx.x & 7, lds, tid, lane, wave);
#endif
          } else { const int u = blockIdx.x - 128;
#ifndef NO_SSD
#ifndef REPS
#define REPS 1
#endif
#pragma unroll 1
            for (int rs = 0; rs < REPS; ++rs) ssd_unit(ap, l, u >> 3, u & 7, lds, tid, lane, wave);
#endif
#ifndef NO_S5
#pragma unroll 1
            for (int s = u; s < 512; s += 128) s5_unit(ap, l, s >> 5, s & 31, lds, tid, lane, wave);
#endif
            xcd_barrier(xsub);
            { KArgs ap3 = kargs(); ssd_norm_rows(ap3, l, u * NWAVES + wave, 128 * NWAVES, lane); }
            { KArgs ap3 = kargs(); unsigned char* ws3 = ap3->ws;
              pg8::Gemm g_{(const pg8::bf16_t*)(ws3 + WS_ZG), (const pg8::bf16_t*)(ws3 + WS_GLU), MTOK, 512, 512}; pg8::StaticOrder S_; S_.init(MTOK, 512, 128, u);
              pg8::EpiGlu EG{(const bf16_t*)(ws3 + WS_ZG), (bf16_t*)(ws3 + WS_YC), ap3->in[31] + l * 512}; pg8::gemm_phase<pg8::EpiGlu, pg8::StaticOrder, true, true>(lds, g_, S_, EG); }
            { KArgs ap2 = kargs(); unsigned char* ws2 = ap2->ws;
              pg8::Gemm g_{(const pg8::bf16_t*)(ws2 + WS_H), (const pg8::bf16_t*)(ws2 + WS_WG + (size_t)2 * 1024 * 1024 * 2), MTOK, 1024, 1024}; pg8::StaticOrder S_; S_.init(MTOK, 1024, 128, u);
              pg8::EpiSigU8 E8{ws2 + WS_GC8}; pg8::gemm_phase<pg8::EpiSigU8, pg8::StaticOrder, true, true>(lds, g_, S_, E8); }
          } }
        xcd_barrier(xbar);
        if (PHM & 4) {
            { FRESH(); pg8::EpiStore ES{(bf16_t*)(ws + WS_TT), 1024}; GEMM_PHASE(pg8::EpiStore, WS_YA, WS_PA, 1024, 512, ES); }
            { FRESH(); pg8::EpiGate<true> EG{(const bf16_t*)(ws + WS_TT), (bf16_t*)(ws + WS_MERGED)}; GEMM_PHASE(pg8::EpiGate<true>, WS_H, WS_WG, 1024, 1024, EG); }
            { FRESH(); pg8::EpiStore ES{(bf16_t*)(ws + WS_TT), 1024}; GEMM_PHASE(pg8::EpiStore, WS_YB, WS_PB, 1024, 512, ES); }
            { FRESH(); pg8::EpiGate<false> EG{(const bf16_t*)(ws + WS_TT), (bf16_t*)(ws + WS_MERGED)}; GEMM_PHASE(pg8::EpiGate<false>, WS_H, WS_WG + (size_t)1024 * 1024 * 2, 1024, 1024, EG); }
            { FRESH(); pg8::EpiMulAccU8 EM{ws + WS_GC8, (bf16_t*)(ws + WS_MERGED)}; GEMM_PHASE(pg8::EpiMulAccU8, WS_YC, WS_PC, 1024, 512, EM); }
        }
        xcd_barrier(xbar);
        if (PHM & 8) { FRESH();
            if (l == 0) { pg8::EpiResid<false> E{(const void*)ap->in[0], (bf16_t*)ap->out}; GEMM_PHASE(pg8::EpiResid<false>, WS_MERGED, WS_WOUT, 1024, 1024, E); }
            else { pg8::EpiResid<true> E{(const void*)ap->out, (bf16_t*)ap->out}; GEMM_PHASE(pg8::EpiResid<true>, WS_MERGED, WS_WOUT, 1024, 1024, E); } }
        xcd_barrier(xbar);
        { FRESH(); rmsnorm_rows<false, true>((const void*)ap->out, ap->in[34] + l * DM, (bf16_t*)(ws + WS_H), nullptr, nullptr, gw, NGW, lane); }
        xcd_barrier(xbar);
        if (PHM & 16) { FRESH(); pg8::EpiSwiglu E{(bf16_t*)(ws + WS_ACT)}; GEMM_PHASE(pg8::EpiSwiglu, WS_H, WS_FIN, 2 * FFH, 1024, E); }
        xcd_barrier(xbar);
        if (PHM & 32) { FRESH(); pg8::EpiResid<true> E{(const void*)ap->out, l == DEPTH - 1 ? (bf16_t*)(ws + WS_XF) : (bf16_t*)ap->out}; GEMM_PHASE(pg8::EpiResid<true>, WS_ACT, WS_FOUT, 1024, FFH, E); }
        xcd_barrier(xbar);
    }
    { KArgs ap = kargs(); final_norm_rows((const bf16_t*)(ap->ws + WS_XF), ap->out, ap->in[37], gw, NGW, lane); }
}

extern "C" void kernel_launch(void* const* d_in, const int* in_sizes, int n_in, void* d_out, int out_size, void* d_ws, size_t ws_size, hipStream_t stream) {
    static int grid = 0;
    if (grid == 0) {
        if (n_in != 38 || out_size != MTOK * DM || ws_size < WS_END) { fprintf(stderr, "kernel_launch: unexpected problem (n_in %d out %d ws %zu, need %zu)\n", n_in, out_size, ws_size, (size_t)WS_END); grid = -1; return; }
        int dev = 0, cus = 0, per_cu = 0;
        (void)hipGetDevice(&dev); (void)hipDeviceGetAttribute(&cus, hipDeviceAttributeMultiprocessorCount, dev);
        if (hipFuncSetAttribute((const void*)hybrid_fwd, hipFuncAttributeMaxDynamicSharedMemorySize, LDS_BYTES) != hipSuccess) { fprintf(stderr, "kernel_launch: hipFuncSetAttribute failed\n"); grid = -1; return; }
        if (hipOccupancyMaxActiveBlocksPerMultiprocessor(&per_cu, (const void*)hybrid_fwd, NTHR, LDS_BYTES) != hipSuccess || per_cu < 1) { fprintf(stderr, "kernel_launch: occupancy query says %d\n", per_cu); per_cu = 1; }
        (void)hipGetLastError();
        grid = cus;
        if (grid != 256) { fprintf(stderr, "kernel_launch: expected 256 CUs, got %d\n", grid); grid = -1; return; }
    }
    if (grid < 0) return;
    Args a{};
    for (int i = 0; i < 38; ++i) a.in[i] = (const float*)d_in[i];
    a.out = (float*)d_out; a.ws = (unsigned char*)d_ws;
    (void)hipMemsetAsync(d_ws, 0, 32768, stream);
    void* args[] = {&a};
    hipError_t e = hipLaunchCooperativeKernel((const void*)hybrid_fwd, dim3(grid), dim3(NTHR), args, LDS_BYTES, stream);
    if (e != hipSuccess) fprintf(stderr, "cooperative launch failed: %s (grid %d)\n", hipGetErrorString(e), grid);
}
```
